# Optimizing an MI355X kernel written in HIP

```python
import jax, jax.numpy as jnp
from jax import lax
import numpy as np

D_MODEL = 1024
BATCH = 8
SEQ = 4096
DEPTH = 1
DEC_BATCH = 32
DEC_SEQ = 2048
PAST_LEN = 128

HEAD_DIM = 64
A_HEADS = D_MODEL // 128
A_KV_HEADS = 2
A_GROUP = A_HEADS // A_KV_HEADS
B_HEADS = D_MODEL // 128
D_FF = 4 * D_MODEL
GRID_W = 64
Q_BLOCK = 128
NA_WIN_ROWS = 8
NA_WIN_COLS = 16
ROPE_THETA = 10000.0
AXIS_ROPE_DIM = HEAD_DIM // 2
EPS = 1e-6
NEG_INF = -1e30

A_Q_W = A_HEADS * HEAD_DIM
A_KV_W = A_KV_HEADS * HEAD_DIM
B_W = B_HEADS * HEAD_DIM
W_IN_SPLITS = (A_Q_W, A_KV_W, A_KV_W, B_W, B_W, B_W, D_MODEL, D_MODEL)
W_IN_COLS = sum(W_IN_SPLITS)

kernel_name = "gated_gqa_axialrope_natten_encoder"


def _rmsnorm(x, g):
    xf = x.astype(jnp.float32)
    y = xf * lax.rsqrt(jnp.mean(xf * xf, axis=-1, keepdims=True) + EPS)
    return (y * g.astype(jnp.float32)).astype(x.dtype)


def _rope_tables(seq_len):
    t = jnp.arange(seq_len, dtype=jnp.int32)
    row = (t // GRID_W).astype(jnp.float32)
    col = (t % GRID_W).astype(jnp.float32)
    inv = ROPE_THETA ** (-jnp.arange(0, AXIS_ROPE_DIM, 2, dtype=jnp.float32) / AXIS_ROPE_DIM)
    ang = jnp.concatenate([row[:, None] * inv, col[:, None] * inv], axis=-1)
    return jnp.cos(ang), jnp.sin(ang)


def _apply_rope(x, cos, sin):
    shp = x.shape
    xf = x.astype(jnp.float32).reshape(shp[:-1] + (shp[-1] // 2, 2))
    bshape = (1, shp[1]) + (1,) * (x.ndim - 3) + (shp[-1] // 2,)
    c = cos.reshape(bshape)
    s = sin.reshape(bshape)
    x0, x1 = xf[..., 0], xf[..., 1]
    out = jnp.stack([x0 * c - x1 * s, x0 * s + x1 * c], axis=-1)
    return out.reshape(shp).astype(x.dtype)


def _gqa_attention(q, k, v):
    B, S = q.shape[0], q.shape[1]
    nblk = S // Q_BLOCK
    scale = HEAD_DIM ** -0.5
    qb = q.reshape(B, nblk, Q_BLOCK, A_KV_HEADS, A_GROUP, HEAD_DIM).swapaxes(0, 1)

    def block(qi):
        s = jnp.einsum('bqkgd,bskd->bkgqs', qi, k, preferred_element_type=jnp.float32) * scale
        p = jax.nn.softmax(s, axis=-1)
        return jnp.einsum('bkgqs,bskd->bqkgd', p.astype(v.dtype), v)

    o = lax.map(block, qb)
    return o.swapaxes(0, 1).reshape(B, S, A_Q_W)


def _neighbourhood_attention(q, k, v, rpb):
    B, S = q.shape[0], q.shape[1]
    rows = S // GRID_W
    wr = min(NA_WIN_ROWS, rows)
    q_rows = Q_BLOCK // GRID_W
    band = min(wr + q_rows - 1, rows)
    nkeys = band * GRID_W
    nblk = S // Q_BLOCK
    scale = HEAD_DIM ** -0.5
    kg = k.reshape(B, rows, GRID_W, B_HEADS, HEAD_DIM)
    vg = v.reshape(B, rows, GRID_W, B_HEADS, HEAD_DIM)
    qb = q.reshape(B, nblk, Q_BLOCK, B_HEADS, HEAD_DIM).swapaxes(0, 1)

    q_r_local = jnp.arange(Q_BLOCK, dtype=jnp.int32) // GRID_W
    q_c = jnp.arange(Q_BLOCK, dtype=jnp.int32) % GRID_W
    k_r_local = jnp.arange(nkeys, dtype=jnp.int32) // GRID_W
    k_c = jnp.arange(nkeys, dtype=jnp.int32) % GRID_W
    col_start = jnp.clip(q_c - NA_WIN_COLS // 2, 0, GRID_W - NA_WIN_COLS)
    col_mask = (k_c[None, :] >= col_start[:, None]) & (k_c[None, :] < col_start[:, None] + NA_WIN_COLS)
    dc_idx = jnp.clip(k_c[None, :] - q_c[:, None] + NA_WIN_COLS - 1, 0, 2 * NA_WIN_COLS - 2)

    def block(args):
        blk, qi = args
        q_r = blk * q_rows + q_r_local
        row_start = jnp.clip(q_r - wr // 2, 0, rows - wr)
        b0 = jnp.minimum(row_start[0], rows - band)
        kb = lax.dynamic_slice_in_dim(kg, b0, band, axis=1).reshape(B, nkeys, B_HEADS, HEAD_DIM)
        vb = lax.dynamic_slice_in_dim(vg, b0, band, axis=1).reshape(B, nkeys, B_HEADS, HEAD_DIM)
        k_r = b0 + k_r_local
        row_mask = (k_r[None, :] >= row_start[:, None]) & (k_r[None, :] < row_start[:, None] + wr)
        mask = row_mask & col_mask
        dr_idx = jnp.clip(k_r[None, :] - q_r[:, None] + NA_WIN_ROWS - 1, 0, 2 * NA_WIN_ROWS - 2)
        bias = rpb[:, dr_idx, dc_idx].astype(jnp.float32)
        s = jnp.einsum('bqhd,bkhd->bhqk', qi, kb, preferred_element_type=jnp.float32) * scale + bias[None]
        s = jnp.where(mask[None, None], s, NEG_INF)
        p = jax.nn.softmax(s, axis=-1)
        return jnp.einsum('bhqk,bkhd->bqhd', p.astype(vb.dtype), vb)

    o = lax.map(block, (jnp.arange(nblk, dtype=jnp.int32), qb))
    return o.swapaxes(0, 1).reshape(B, S, B_W)


def _token_mixer(xn, w_in, q_norm_g, k_norm_g, rpb, w_proj_a, w_proj_b, w_out):
    B, S, _ = xn.shape
    z = xn @ w_in
    idx = tuple(int(i) for i in np.cumsum(W_IN_SPLITS)[:-1])
    qa, ka, va, qb, kb, vb, ga, gb = jnp.split(z, idx, axis=-1)
    cos, sin = _rope_tables(S)
    qa = _apply_rope(_rmsnorm(qa.reshape(B, S, A_KV_HEADS, A_GROUP, HEAD_DIM), q_norm_g), cos, sin)
    ka = _apply_rope(_rmsnorm(ka.reshape(B, S, A_KV_HEADS, HEAD_DIM), k_norm_g), cos, sin)
    va = va.reshape(B, S, A_KV_HEADS, HEAD_DIM)
    o_a = _gqa_attention(qa, ka, va)
    o_b = _neighbourhood_attention(qb.reshape(B, S, B_HEADS, HEAD_DIM),
                                   kb.reshape(B, S, B_HEADS, HEAD_DIM),
                                   vb.reshape(B, S, B_HEADS, HEAD_DIM), rpb)
    merged = jax.nn.sigmoid(ga) * (o_a @ w_proj_a) + jax.nn.sigmoid(gb) * (o_b @ w_proj_b)
    return merged @ w_out


def _trunk(x, norm_mix_g, w_in, a_q_norm_g, a_k_norm_g, b_rel_pos_bias, w_proj_a, w_proj_b,
           w_out, norm_mlp_g, w_mlp_up, w_mlp_down, norm_final_g):
    h = x
    for l in range(DEPTH):
        h = h + _token_mixer(_rmsnorm(h, norm_mix_g[l]), w_in[l], a_q_norm_g[l], a_k_norm_g[l],
                             b_rel_pos_bias[l], w_proj_a[l], w_proj_b[l], w_out[l])
        hn = _rmsnorm(h, norm_mlp_g[l])
        h = h + jnp.square(jax.nn.relu(hn @ w_mlp_up[l])) @ w_mlp_down[l]
    return _rmsnorm(h, norm_final_g)


def setup_inputs(seed: int = 0) -> dict:
    key = jax.random.key(seed)
    ks = jax.random.split(key, 16)
    f32 = jnp.float32
    nrm = lambda k, shape, s: jax.random.normal(k, shape, f32) * s
    return {
        "x_prompt": nrm(ks[0], (BATCH, SEQ, D_MODEL), 1.0),
        "x_sample": nrm(ks[1], (DEC_BATCH, DEC_SEQ, D_MODEL), 1.0),
        "norm_mix_g": 1.0 + nrm(ks[2], (DEPTH, D_MODEL), 0.02),
        "w_in": nrm(ks[3], (DEPTH, D_MODEL, W_IN_COLS), D_MODEL ** -0.5),
        "a_q_norm_g": 1.0 + nrm(ks[4], (DEPTH, HEAD_DIM), 0.02),
        "a_k_norm_g": 1.0 + nrm(ks[5], (DEPTH, HEAD_DIM), 0.02),
        "b_rel_pos_bias": nrm(ks[6], (DEPTH, B_HEADS, 2 * NA_WIN_ROWS - 1, 2 * NA_WIN_COLS - 1), 0.1),
        "w_proj_a": nrm(ks[7], (DEPTH, A_Q_W, D_MODEL), A_Q_W ** -0.5),
        "w_proj_b": nrm(ks[8], (DEPTH, B_W, D_MODEL), B_W ** -0.5),
        "w_out": nrm(ks[9], (DEPTH, D_MODEL, D_MODEL), D_MODEL ** -0.5),
        "norm_mlp_g": 1.0 + nrm(ks[10], (DEPTH, D_MODEL), 0.02),
        "w_mlp_up": nrm(ks[11], (DEPTH, D_MODEL, D_FF), D_MODEL ** -0.5),
        "w_mlp_down": nrm(ks[12], (DEPTH, D_FF, D_MODEL), D_FF ** -0.5),
        "norm_final_g": 1.0 + nrm(ks[13], (D_MODEL,), 0.02),
    }


def reference(x_prompt, x_sample, norm_mix_g, w_in, a_q_norm_g, a_k_norm_g, b_rel_pos_bias,
              w_proj_a, w_proj_b, w_out, norm_mlp_g, w_mlp_up, w_mlp_down, norm_final_g):
    y_prompt = _trunk(x_prompt, norm_mix_g, w_in, a_q_norm_g, a_k_norm_g, b_rel_pos_bias,
                      w_proj_a, w_proj_b, w_out, norm_mlp_g, w_mlp_up, w_mlp_down, norm_final_g)
    y_sample = _trunk(x_sample, norm_mix_g, w_in, a_q_norm_g, a_k_norm_g, b_rel_pos_bias,
                      w_proj_a, w_proj_b, w_out, norm_mlp_g, w_mlp_up, w_mlp_down, norm_final_g)
    return (y_prompt, y_sample)
```

```cpp
#include <hip/hip_runtime.h>
#include <hip/hip_cooperative_groups.h>
#include <hip/hip_bf16.h>
#include <cstdio>
#include <cstdint>
#include <cmath>
namespace cg = cooperative_groups;

__device__ __forceinline__ int lane_now() { int l; asm volatile("v_mbcnt_lo_u32_b32 %0, -1, 0\n\tv_mbcnt_hi_u32_b32 %0, -1, %0" : "=v"(l)); return l; }
namespace pg8 {
#define PG8_LAS __attribute__((address_space(3)))
typedef unsigned short bf16_t;
typedef short bf16x8 __attribute__((ext_vector_type(8)));
typedef float f32x4 __attribute__((ext_vector_type(4)));
typedef unsigned u32x4 __attribute__((ext_vector_type(4)));
constexpr int BM = 256, BK = 64, HALF = 128, HTB = HALF * BK * 2, STAGE_BYTES = 8 * HTB, NXCD = 8, WGM = 8;
constexpr float C2Q = 0.125f * 1.4426950408889634f;
constexpr float LOG2E = 1.4426950408889634f;

__host__ __device__ __forceinline__ int lds_byte(int r, int c) { const int st = (r >> 4) * 2 + (c >> 5), rr = r & 15, cc = c & 31, ob = rr * 64 + cc * 2; return st * 1024 + (ob ^ (((ob >> 9) & 1) << 5)); }
__host__ __device__ __forceinline__ void stage_rc(int b, int& R, int& C) { const int st = b / 1024, sb = b % 1024, swz = sb ^ (((sb >> 9) & 1) << 5); R = (st >> 1) * 16 + swz / 64; C = (st & 1) * 32 + (swz % 64) / 2; }
__host__ __device__ __forceinline__ int perm32(int rho) { const int n = rho >> 4, i = rho & 15; return 8 * (i >> 2) + 4 * n + (i & 3); }

struct Unit { int pm, pn; };
struct Gemm { const bf16_t* A; const bf16_t* Bt; int lda, ldb; int M, N, K; };

struct StaticOrder {
    int nM, nN, nwg, G, c; bool rev;
    __host__ __device__ void init(int M, int N, int G_, int c_) { nM = M / BM; nN = N / BM; nwg = nM * nN; G = G_; c = c_; rev = false; }
    __host__ __device__ bool next(int i, Unit& u) const {
        const long L = (long)i * G + c; if (L >= nwg) return false;
        int wgid = (int)L; { const int q = nwg / NXCD, r = nwg % NXCD, xcd = wgid % NXCD, off = wgid / NXCD; wgid = (xcd < r ? xcd * (q + 1) : r * (q + 1) + (xcd - r) * q) + off; }
        const int nig = WGM * nN, gid = wgid / nig, fm = gid * WGM, gsz = (nM - fm) < WGM ? (nM - fm) : WGM;
        u.pm = fm + ((wgid % nig) % gsz); u.pn = (wgid % nig) / gsz; if (rev) u.pm = nM - 1 - u.pm; return true;
    }
    __device__ __forceinline__ void a_ready(const Unit&) const {}
    __device__ __forceinline__ void done(const Unit&) const {}
};

typedef float f32x2 __attribute__((ext_vector_type(2)));
typedef __bf16 bf16x2v __attribute__((ext_vector_type(2)));
__device__ __forceinline__ unsigned pkbf(float lo, float hi) { f32x2 v = {lo, hi}; bf16x2v b = __builtin_convertvector(v, bf16x2v); return __builtin_bit_cast(unsigned, b); }
__device__ __forceinline__ float bflo(unsigned w) { return __uint_as_float(w << 16); }
__device__ __forceinline__ float bfhi(unsigned w) { return __uint_as_float(w & 0xffff0000u); }
__device__ __forceinline__ u32x4 pk8(const f32x4 a, const f32x4 b) { u32x4 w; w.x = pkbf(a[0], a[1]); w.y = pkbf(a[2], a[3]); w.z = pkbf(b[0], b[1]); w.w = pkbf(b[2], b[3]); return w; }
__device__ __forceinline__ float sigm(float v) { return __builtin_amdgcn_rcpf(1.0f + __builtin_amdgcn_exp2f(-LOG2E * v)); }
__device__ __forceinline__ float sumsq4(const f32x4 a) { return (a[0] * a[0] + a[1] * a[1]) + (a[2] * a[2] + a[3] * a[3]); }

struct EpiIn {
    static constexpr bool PERM = true, AFTER_DRAIN = false, HAS_PRE = true; static constexpr int MIDK = 0;
    bf16_t *QAB, *KAVA, *KB, *VB, *G; const float* qg; const float* kg; const float* rope; const float* ssx;
    __device__ __forceinline__ void pre(const Unit& u, int wr, int fr, float (&pf)[8]) const {
        const int row0 = u.pm * BM + wr * 64 + fr;
#pragma unroll
        for (int ai = 0; ai < 2; ++ai)
#pragma unroll
            for (int m = 0; m < 4; ++m) pf[ai * 4 + m] = ssx[(size_t)(row0 + ai * HALF + m * 16)];
    }
    __device__ __forceinline__ void operator()(const f32x4 (&acc)[2][2][4][2], const Unit& u, int wr, int wc, int fr, int fq, const float (&pf)[8]) const {
        const int pn = u.pn; const int row0 = u.pm * BM + wr * 64 + fr;
        if (pn < 3) {
            const bool isq = pn < 2, nrm = isq || wc < 2;
            bf16_t* dst = isq ? QAB : KAVA; const int pitch = isq ? 1024 : 256; const int colb = (isq ? 256 * pn : 0) + 64 * wc + 8 * fq;
            const float osc = isq ? C2Q : 1.f; const float* gp = isq ? qg : kg;
            f32x4 gv[2][2];
#pragma unroll
            for (int bj = 0; bj < 2; ++bj)
#pragma unroll
                for (int n = 0; n < 2; ++n) gv[bj][n] = *(const f32x4*)(gp + 32 * bj + 8 * fq + 4 * n);
            const bool prompt = u.pm < 128; const int smask = prompt ? 4095 : 2047, toff = prompt ? 0 : 32768;
#pragma unroll
            for (int ai = 0; ai < 2; ++ai) {
                const int grow = (((u.pm * BM + ai * HALF + wr * 64) - toff) & smask) >> 6;
                const f32x4 cr0 = *(const f32x4*)(rope + (grow * 16 + 4 * fq) * 2), cr1 = *(const f32x4*)(rope + (grow * 16 + 4 * fq + 2) * 2);
#pragma unroll
                for (int m = 0; m < 4; ++m) {
                    const int row = row0 + ai * HALF + m * 16; const int gcol = m * 16 + fr; const float rsx = __builtin_amdgcn_rsqf(pf[ai * 4 + m] * (1.0f / 1024.0f) + 1e-6f);
                    f32x4 v[2][2];
#pragma unroll
                    for (int bj = 0; bj < 2; ++bj)
#pragma unroll
                        for (int n = 0; n < 2; ++n) v[bj][n] = acc[ai][bj][m][n] * rsx;
                    if (nrm) {
                        float ss = (sumsq4(v[0][0]) + sumsq4(v[0][1])) + (sumsq4(v[1][0]) + sumsq4(v[1][1]));
                        ss += __shfl_xor(ss, 16); ss += __shfl_xor(ss, 32);
                        const float rinv = __builtin_amdgcn_rsqf(ss * (1.0f / 64.0f) + 1e-6f);
                        const f32x4 cc0 = *(const f32x4*)(rope + (gcol * 16 + 4 * fq) * 2), cc1 = *(const f32x4*)(rope + (gcol * 16 + 4 * fq + 2) * 2);
#pragma unroll
                        for (int bj = 0; bj < 2; ++bj)
#pragma unroll
                            for (int n = 0; n < 2; ++n) {
                                const f32x4 x = v[bj][n] * rinv * gv[bj][n]; const f32x4 cs = bj == 0 ? (n == 0 ? cr0 : cr1) : (n == 0 ? cc0 : cc1);
                                f32x4 o; o[0] = x[0] * cs[0] - x[1] * cs[1]; o[1] = x[0] * cs[1] + x[1] * cs[0]; o[2] = x[2] * cs[2] - x[3] * cs[3]; o[3] = x[2] * cs[3] + x[3] * cs[2];
                                v[bj][n] = o * osc; }
                    }
                    bf16_t* rowp = dst + (size_t)row * pitch + colb;
                    *(u32x4*)(rowp) = pk8(v[0][0], v[0][1]); *(u32x4*)(rowp + 32) = pk8(v[1][0], v[1][1]);
                }
            }
        } else {
            const int t = pn - 3; bf16_t* dst; int pitch, colt; float sc = 1.f; bool sg = false;
            if (t < 2) { dst = QAB; pitch = 1024; colt = 512 + 256 * t; sc = C2Q; } else if (t < 4) { dst = KB; pitch = 512; colt = 256 * (t - 2); }
            else if (t < 6) { dst = VB; pitch = 512; colt = 256 * (t - 4); } else { dst = G; pitch = 2048; colt = 128 * (t - 6); sg = true; }
            const int col0 = colt + wc * 32 + 8 * fq;
            if (sg) {
#pragma unroll
                for (int ai = 0; ai < 2; ++ai)
#pragma unroll
                    for (int m = 0; m < 4; ++m) { bf16_t* rowp = dst + (size_t)(row0 + ai * HALF + m * 16) * pitch + col0; const float rsl = -LOG2E * __builtin_amdgcn_rsqf(pf[ai * 4 + m] * (1.0f / 1024.0f) + 1e-6f);
                        f32x4 r0, r1, s0, s1;
#pragma unroll
                        for (int i = 0; i < 4; ++i) { const float ea0 = __builtin_amdgcn_exp2f(rsl * acc[ai][0][m][0][i]), ea1 = __builtin_amdgcn_exp2f(rsl * acc[ai][0][m][1][i]);
                            const float eb0 = __builtin_amdgcn_exp2f(rsl * acc[ai][1][m][0][i]), eb1 = __builtin_amdgcn_exp2f(rsl * acc[ai][1][m][1][i]);
                            s0[i] = __builtin_amdgcn_rcpf(1.0f + eb0); s1[i] = __builtin_amdgcn_rcpf(1.0f + eb1);
                            r0[i] = (1.0f + eb0) * __builtin_amdgcn_rcpf(1.0f + ea0); r1[i] = (1.0f + eb1) * __builtin_amdgcn_rcpf(1.0f + ea1); }
                        __builtin_nontemporal_store(pk8(r0, r1), (u32x4*)(rowp)); __builtin_nontemporal_store(pk8(s0, s1), (u32x4*)(rowp + 1024)); }
                return;
            }
#pragma unroll
            for (int ai = 0; ai < 2; ++ai)
#pragma unroll
                for (int m = 0; m < 4; ++m) { bf16_t* rowp = dst + (size_t)(row0 + ai * HALF + m * 16) * pitch + col0; const float rsx = __builtin_amdgcn_rsqf(pf[ai * 4 + m] * (1.0f / 1024.0f) + 1e-6f);
#pragma unroll
                    for (int bj = 0; bj < 2; ++bj) { f32x4 v0 = acc[ai][bj][m][0] * rsx, v1 = acc[ai][bj][m][1] * rsx;
                        if (sg) {
#pragma unroll
                            for (int i = 0; i < 4; ++i) { v0[i] = sigm(v0[i]); v1[i] = sigm(v1[i]); } }
                        else { v0 = v0 * sc; v1 = v1 * sc; }
                        *(u32x4*)(rowp + bj * HALF) = pk8(v0, v1); } }
        }
    }
};
struct EpiGate {
    static constexpr bool PERM = true, AFTER_DRAIN = false, HAS_PRE = false; static constexpr int MIDK = 8;
    const bf16_t* G; bf16_t* MG;
    __device__ __forceinline__ void scale(f32x4 (&acc)[2][2][4][2], const Unit& u, int wr, int wc, int fr, int fq, int goff) const {
        asm volatile("" : "+v"(fr), "+v"(fq));
        const int row0 = u.pm * BM + wr * 64 + fr, col0 = u.pn * BM + wc * 32 + 8 * fq;
#pragma unroll
        for (int ai = 0; ai < 2; ++ai)
#pragma unroll
            for (int m = 0; m < 4; ++m) { const size_t row = (size_t)(row0 + ai * HALF + m * 16);
#pragma unroll
                for (int bj = 0; bj < 2; ++bj) { const u32x4 g = *(const u32x4*)(G + row * 2048 + goff + col0 + bj * HALF);
                    f32x4& v0 = acc[ai][bj][m][0]; f32x4& v1 = acc[ai][bj][m][1];
                    v0[0] *= bflo(g.x); v0[1] *= bfhi(g.x); v0[2] *= bflo(g.y); v0[3] *= bfhi(g.y); v1[0] *= bflo(g.z); v1[1] *= bfhi(g.z); v1[2] *= bflo(g.w); v1[3] *= bfhi(g.w); }
                if (m & 1) asm volatile("" ::: "memory"); }
    }
    __device__ __forceinline__ void mid(f32x4 (&acc)[2][2][4][2], const Unit& u, int wr, int wc, int fr, int fq) const { scale(acc, u, wr, wc, fr, fq, 0); }
    __device__ __forceinline__ void operator()(const f32x4 (&acc)[2][2][4][2], const Unit& u, int wr, int wc, int fr, int fq) const {
        asm volatile("" : "+v"(fr), "+v"(fq));
        const int row0 = u.pm * BM + wr * 64 + fr, col0 = u.pn * BM + wc * 32 + 8 * fq;
#pragma unroll
        for (int ai = 0; ai < 2; ++ai)
#pragma unroll
            for (int m = 0; m < 4; ++m) { const size_t row = (size_t)(row0 + ai * HALF + m * 16);
#pragma unroll
                for (int bj = 0; bj < 2; ++bj) { const u32x4 g = *(const u32x4*)(G + row * 2048 + 1024 + col0 + bj * HALF);
                    f32x4 v0 = acc[ai][bj][m][0], v1 = acc[ai][bj][m][1];
                    v0[0] *= bflo(g.x); v0[1] *= bfhi(g.x); v0[2] *= bflo(g.y); v0[3] *= bfhi(g.y); v1[0] *= bflo(g.z); v1[1] *= bfhi(g.z); v1[2] *= bflo(g.w); v1[3] *= bfhi(g.w);
                    *(u32x4*)(MG + row * 1024 + col0 + bj * HALF) = pk8(v0, v1); } }
    }
};
struct EpiH {
    static constexpr bool PERM = true, AFTER_DRAIN = false, HAS_PRE = false; static constexpr int MIDK = 0;
    const bf16_t* XB; bf16_t* HB; float* ss;
    __device__ __forceinline__ void operator()(const f32x4 (&acc)[2][2][4][2], const Unit& u, int wr, int wc, int fr, int fq) const {
        const int row0 = u.pm * BM + wr * 64 + fr, col0 = u.pn * BM + wc * 32 + 8 * fq;
#pragma unroll
        for (int ai = 0; ai < 2; ++ai)
#pragma unroll
            for (int m = 0; m < 4; ++m) { const size_t row = (size_t)(row0 + ai * HALF + m * 16); float s = 0.f;
#pragma unroll
                for (int bj = 0; bj < 2; ++bj) { const size_t off = row * 1024 + col0 + bj * HALF; const u32x4 h = *(const u32x4*)(XB + off);
                    f32x4 a = acc[ai][bj][m][0], b = acc[ai][bj][m][1];
                    a[0] += bflo(h.x); a[1] += bfhi(h.x); a[2] += bflo(h.y); a[3] += bfhi(h.y); b[0] += bflo(h.z); b[1] += bfhi(h.z); b[2] += bflo(h.w); b[3] += bfhi(h.w);
                    s += sumsq4(a) + sumsq4(b); *(u32x4*)(HB + off) = pk8(a, b); }
                s += __shfl_xor(s, 16); s += __shfl_xor(s, 32);
                if (fq == 0) unsafeAtomicAdd(ss + row, s); }
    }
};
struct EpiH2 {
    static constexpr bool PERM = true, AFTER_DRAIN = false, HAS_PRE = false; static constexpr int MIDK = 0;
    bf16_t* HB; float* ss; bf16_t* HO;
    __device__ __forceinline__ void operator()(const f32x4 (&acc)[2][2][4][2], const Unit& u, int wr, int wc, int fr, int fq) const {
        const int row0 = u.pm * BM + wr * 64 + fr, col0 = u.pn * BM + wc * 32 + 8 * fq;
#pragma unroll
        for (int ai = 0; ai < 2; ++ai)
#pragma unroll
            for (int m = 0; m < 4; ++m) { const size_t row = (size_t)(row0 + ai * HALF + m * 16); float s = 0.f;
#pragma unroll
                for (int bj = 0; bj < 2; ++bj) { const size_t off = row * 1024 + col0 + bj * HALF; const u32x4 h = *(const u32x4*)(HB + off);
                    f32x4 a = acc[ai][bj][m][0], b = acc[ai][bj][m][1];
                    a[0] += bflo(h.x); a[1] += bfhi(h.x); a[2] += bflo(h.y); a[3] += bfhi(h.y); b[0] += bflo(h.z); b[1] += bfhi(h.z); b[2] += bflo(h.w); b[3] += bfhi(h.w);
                    s += sumsq4(a) + sumsq4(b); *(u32x4*)(HO + off) = pk8(a, b); }
                s += __shfl_xor(s, 16); s += __shfl_xor(s, 32);
                if (fq == 0) unsafeAtomicAdd(ss + row, s); }
    }
};
struct EpiUp {
    static constexpr bool PERM = true, AFTER_DRAIN = false, HAS_PRE = true; static constexpr int MIDK = 0;
    const float* ss; bf16_t* U;
    __device__ __forceinline__ void pre(const Unit& u, int wr, int fr, float (&pf)[8]) const {
        const int row0 = u.pm * BM + wr * 64 + fr;
#pragma unroll
        for (int ai = 0; ai < 2; ++ai)
#pragma unroll
            for (int m = 0; m < 4; ++m) pf[ai * 4 + m] = ss[(size_t)(row0 + ai * HALF + m * 16)];
    }
    __device__ __forceinline__ void operator()(const f32x4 (&acc)[2][2][4][2], const Unit& u, int wr, int wc, int fr, int fq, const float (&pf)[8]) const {
        const int row0 = u.pm * BM + wr * 64 + fr, col0 = u.pn * BM + wc * 32 + 8 * fq;
#pragma unroll
        for (int ai = 0; ai < 2; ++ai)
#pragma unroll
            for (int m = 0; m < 4; ++m) { const size_t row = (size_t)(row0 + ai * HALF + m * 16); const float rs = __builtin_amdgcn_rsqf(pf[ai * 4 + m] * (1.0f / 1024.0f) + 1e-6f);
#pragma unroll
                for (int bj = 0; bj < 2; ++bj) { f32x4 v0 = acc[ai][bj][m][0] * rs, v1 = acc[ai][bj][m][1] * rs;
#pragma unroll
                    for (int i = 0; i < 4; ++i) { const float a = __builtin_fmaxf(v0[i], 0.f), b = __builtin_fmaxf(v1[i], 0.f); v0[i] = a * a; v1[i] = b * b; }
                    *(u32x4*)(U + row * 4096 + col0 + bj * HALF) = pk8(v0, v1); } }
    }
};

template <class Epi, class Sched, bool ALIGN_EPI = false, bool SP2 = false>
__device__ __forceinline__ void gemm_phase(PG8_LAS unsigned char* lds, const Gemm g, const Sched& S, const Epi& E, const int wave_s) {
    int tid_ = (wave_s << 6) | lane_now(); asm volatile("" : "+v"(tid_));
    const int tid = tid_, wid = __builtin_amdgcn_readfirstlane(tid >> 6), lane = tid & 63, wr = wid >> 2, wc = wid & 3, fr = lane & 15, fq = lane >> 4;
    const int K = g.K, nt = K / BK, lda = g.lda, ldb = g.ldb;
    unsigned voffA[2], voffB[2];
#pragma unroll
    for (int i = 0; i < 2; ++i) { int R, C; stage_rc(tid * 16 + i * 8192, R, C); const int Rb = Epi::PERM ? ((R & ~31) + perm32(R & 31)) : R;
        voffA[i] = (unsigned)(R * lda + C) * 2u; voffB[i] = (unsigned)(Rb * ldb + C) * 2u; }
    const size_t kstep = (size_t)(BK * 2);
    const size_t hA = (size_t)HALF * lda * 2, hB = (size_t)HALF * ldb * 2;
    const size_t tA = 2 * hA, tB = 2 * hB;
    const unsigned ldsw = (unsigned)wid * 1024u;
    const int aoff = lds_byte(wr * 64 + fr, fq * 8), boff = lds_byte(wc * 32 + fr, fq * 8);
#define PG8_SA(b, h) (((b) * 2 + (h)) * HTB)
#define PG8_SB(b, h) ((4 + (b) * 2 + (h)) * HTB)
#define PG8_STAGE(bufoff, gbase, voff) do { _Pragma("unroll") for (int _i = 0; _i < 2; ++_i) \
        __builtin_amdgcn_global_load_lds((const unsigned*)((const char*)(gbase) + (voff)[_i]), (PG8_LAS unsigned*)(lds + (bufoff) + ldsw + _i * 8192), 16, 0, 0); } while (0)
#define PG8_LDA(dst, b, h) do { _Pragma("unroll") for (int m = 0; m < 4; ++m) _Pragma("unroll") for (int k = 0; k < 2; ++k) dst[m][k] = *(const PG8_LAS bf16x8*)(lds + PG8_SA(b, h) + aoff + m * 2048 + k * 1024); } while (0)
#define PG8_LDB(dst, b, h) do { _Pragma("unroll") for (int n = 0; n < 2; ++n) _Pragma("unroll") for (int k = 0; k < 2; ++k) dst[n][k] = *(const PG8_LAS bf16x8*)(lds + PG8_SB(b, h) + boff + n * 2048 + k * 1024); } while (0)
#define PG8_MMA(ai, bj, At, Bt) do { __builtin_amdgcn_s_setprio(1); _Pragma("unroll") for (int m = 0; m < 4; ++m) _Pragma("unroll") for (int n = 0; n < 2; ++n) _Pragma("unroll") for (int k = 0; k < 2; ++k) \
        acc[ai][bj][m][n] = __builtin_amdgcn_mfma_f32_16x16x32_bf16(Bt[n][k], At[m][k], acc[ai][bj][m][n], 0, 0, 0); __builtin_amdgcn_s_setprio(0); } while (0)
#define PG8_WAIT_V(n) asm volatile("s_waitcnt vmcnt(" #n ")" ::: "memory")
#define PG8_WAIT_L(n) asm volatile("s_waitcnt lgkmcnt(" #n ")" ::: "memory")
#define PG8_BAR __builtin_amdgcn_s_barrier()
#define PG8_SCHED __builtin_amdgcn_sched_barrier(0)
    Unit cur, nxt; int ui = 0; float pf[8] = {0.f, 0.f, 0.f, 0.f, 0.f, 0.f, 0.f, 0.f};
    if (!S.next(0, cur)) return;
    f32x4 acc[2][2][4][2];
#pragma unroll
    for (int a = 0; a < 2; ++a)
#pragma unroll
        for (int b = 0; b < 2; ++b)
#pragma unroll
            for (int m = 0; m < 4; ++m)
#pragma unroll
                for (int n = 0; n < 2; ++n) acc[a][b][m][n] = (f32x4){0.f, 0.f, 0.f, 0.f};
    bf16x8 At[4][2], B0[2][2], B1[2][2];
    const char* cA = (const char*)g.A + (size_t)cur.pm * tA; const char* cB = (const char*)g.Bt + (size_t)cur.pn * tB;
    S.a_ready(cur);
    if constexpr (SP2) {
        PG8_STAGE(PG8_SB(0, 0), cB, voffB); PG8_STAGE(PG8_SB(0, 1), cB + hB, voffB); PG8_STAGE(PG8_SA(0, 0), cA, voffA); PG8_STAGE(PG8_SA(0, 1), cA + hA, voffA);
        if (wr == 1) PG8_BAR;
        PG8_WAIT_V(2); PG8_BAR;
        PG8_STAGE(PG8_SB(1, 0), cB + kstep, voffB); PG8_STAGE(PG8_SA(1, 0), cA + kstep, voffA); PG8_STAGE(PG8_SB(1, 1), cB + hB + kstep, voffB);
        PG8_WAIT_V(6); PG8_BAR;
    } else {
        PG8_STAGE(PG8_SB(0, 0), cB, voffB); PG8_STAGE(PG8_SA(0, 0), cA, voffA); PG8_STAGE(PG8_SB(0, 1), cB + hB, voffB); PG8_STAGE(PG8_SA(0, 1), cA + hA, voffA);
        if (wr == 1) PG8_BAR;
        PG8_WAIT_V(4); PG8_BAR;
        PG8_STAGE(PG8_SB(1, 0), cB + kstep, voffB); PG8_STAGE(PG8_SA(1, 0), cA + kstep, voffA); PG8_STAGE(PG8_SB(1, 1), cB + hB + kstep, voffB);
        PG8_WAIT_V(6); PG8_BAR;
    }
    for (;;) {
        const bool has_next = S.next(ui + 1, nxt);
        const char* nA = has_next ? (const char*)g.A + (size_t)nxt.pm * tA : cA; const char* nB = has_next ? (const char*)g.Bt + (size_t)nxt.pn * tB : cB;
        for (int t = 0; t < nt; t += 2) {
            if constexpr (Epi::MIDK > 0) { if (t == Epi::MIDK) E.mid(acc, cur, wr, wc, fr, fq); }
            const bool last = (t == nt - 2);
            if constexpr (Epi::HAS_PRE) { if (last) E.pre(cur, wr, fr, pf); }
            const char* a1 = cA + (size_t)(t + 1) * kstep;
            const char* a2 = last ? nA : cA + (size_t)(t + 2) * kstep; const char* b2 = last ? nB : cB + (size_t)(t + 2) * kstep;
            const char* a3 = a2 + kstep; const char* b3 = b2 + kstep;
            if (last && has_next) S.a_ready(nxt);
            if constexpr (SP2) {
            PG8_LDB(B0, 0, 0); PG8_LDB(B1, 0, 1); PG8_SCHED; PG8_LDA(At, 0, 0); PG8_STAGE(PG8_SA(1, 1), a1 + hA, voffA);
            PG8_WAIT_V(8); PG8_WAIT_L(0); PG8_BAR; PG8_MMA(0, 0, At, B0); PG8_MMA(0, 1, At, B1); PG8_BAR; PG8_SCHED;
            PG8_LDA(At, 0, 1); PG8_STAGE(PG8_SB(0, 0), b2, voffB); PG8_STAGE(PG8_SB(0, 1), b2 + hB, voffB); PG8_STAGE(PG8_SA(0, 0), a2, voffA);
            PG8_WAIT_V(8); PG8_WAIT_L(0); PG8_BAR; PG8_MMA(1, 0, At, B0); PG8_MMA(1, 1, At, B1); PG8_BAR; PG8_SCHED;
            PG8_LDB(B0, 1, 0); PG8_LDB(B1, 1, 1); PG8_SCHED; PG8_LDA(At, 1, 0); PG8_STAGE(PG8_SA(0, 1), a2 + hA, voffA);
            PG8_WAIT_V(8); PG8_WAIT_L(0); PG8_BAR; PG8_MMA(0, 0, At, B0); PG8_MMA(0, 1, At, B1); PG8_BAR; PG8_SCHED;
            PG8_LDA(At, 1, 1); PG8_STAGE(PG8_SB(1, 0), b3, voffB); PG8_STAGE(PG8_SB(1, 1), b3 + hB, voffB); PG8_STAGE(PG8_SA(1, 0), a3, voffA);
            PG8_WAIT_V(8); PG8_WAIT_L(0); PG8_BAR; PG8_MMA(1, 0, At, B0); PG8_MMA(1, 1, At, B1); PG8_BAR; PG8_SCHED;
            } else {
            PG8_LDB(B0, 0, 0); PG8_SCHED; PG8_LDA(At, 0, 0); PG8_STAGE(PG8_SA(1, 1), a1 + hA, voffA);
            PG8_WAIT_L(8); PG8_BAR; PG8_WAIT_L(0); PG8_MMA(0, 0, At, B0); PG8_BAR; PG8_SCHED;
            PG8_LDB(B1, 0, 1); PG8_STAGE(PG8_SB(0, 0), b2, voffB);
            PG8_BAR; PG8_WAIT_L(0); PG8_MMA(0, 1, At, B1); PG8_BAR;
            PG8_LDA(At, 0, 1); PG8_STAGE(PG8_SA(0, 0), a2, voffA);
            PG8_BAR; PG8_WAIT_L(0); PG8_MMA(1, 0, At, B0); PG8_BAR; PG8_SCHED;
            PG8_STAGE(PG8_SB(0, 1), b2 + hB, voffB);
            PG8_WAIT_V(6); PG8_BAR; PG8_MMA(1, 1, At, B1); PG8_BAR;
            PG8_LDB(B0, 1, 0); PG8_SCHED; PG8_LDA(At, 1, 0); PG8_STAGE(PG8_SA(0, 1), a2 + hA, voffA);
            PG8_WAIT_L(8); PG8_BAR; PG8_WAIT_L(0); PG8_MMA(0, 0, At, B0); PG8_BAR; PG8_SCHED;
            PG8_LDB(B1, 1, 1); PG8_STAGE(PG8_SB(1, 0), b3, voffB);
            PG8_BAR; PG8_WAIT_L(0); PG8_MMA(0, 1, At, B1); PG8_BAR;
            PG8_LDA(At, 1, 1); PG8_STAGE(PG8_SA(1, 0), a3, voffA);
            PG8_BAR; PG8_WAIT_L(0); PG8_MMA(1, 0, At, B0); PG8_BAR; PG8_SCHED;
            PG8_STAGE(PG8_SB(1, 1), b3 + hB, voffB);
            PG8_WAIT_V(6); PG8_BAR; PG8_MMA(1, 1, At, B1); PG8_BAR;
            }
        }
        if constexpr (ALIGN_EPI) { if (wr == 0) PG8_BAR; }
        if constexpr (!Epi::AFTER_DRAIN) { if constexpr (Epi::HAS_PRE) E(acc, cur, wr, wc, fr, fq, pf); else E(acc, cur, wr, wc, fr, fq); S.done(cur); }
        if (!has_next) break;
#pragma unroll
        for (int a = 0; a < 2; ++a)
#pragma unroll
            for (int b = 0; b < 2; ++b)
#pragma unroll
                for (int m = 0; m < 4; ++m)
#pragma unroll
                    for (int n = 0; n < 2; ++n) acc[a][b][m][n] = (f32x4){0.f, 0.f, 0.f, 0.f};
        cur = nxt; cA = nA; cB = nB; ++ui;
        if constexpr (ALIGN_EPI) { if (wr == 1) PG8_BAR; }
    }
    PG8_WAIT_V(0);
    if constexpr (!ALIGN_EPI) { if (wr == 0) PG8_BAR; }
    PG8_BAR;
    if constexpr (Epi::AFTER_DRAIN) { E.fused(acc, cur, wr, wc, fr, fq, lds, wid, lane); S.done(cur); }
#undef PG8_SA
#undef PG8_SB
#undef PG8_STAGE
#undef PG8_LDA
#undef PG8_LDB
#undef PG8_MMA
#undef PG8_WAIT_V
#undef PG8_WAIT_L
#undef PG8_BAR
#undef PG8_SCHED
}
}

namespace attn_body {
using bf16=__hip_bfloat16;
using bf16x8=__attribute__((ext_vector_type(8)))short;
using s16x4=__attribute__((ext_vector_type(4)))short;
using f32x16=__attribute__((ext_vector_type(16)))float;
using u32x4=__attribute__((ext_vector_type(4)))unsigned;
constexpr int D=64;
constexpr int NW=8,QBLK=32,QB=QBLK*NW,KVBLK=64;
constexpr int NA_TBL_OFF=88064;
typedef const __attribute__((address_space(3))) float* na_lptr;
__device__ __forceinline__ int crow(int r,int hi){return (r&3)+8*(r>>2)+4*hi;}
#define SBAR() __builtin_amdgcn_sched_barrier(0)
#define ATTN_STORE16(p,v) (*(u32x4*)(p)=(v))
#define NA_SETUP \
  int na_qr=0,na_off=0,na_rsw=0; unsigned na_mw=0u; na_lptr na_tbl=(na_lptr)((const __attribute__((address_space(3))) char*)shm+NA_TBL_OFF); \
  if constexpr(NA){ na_qr=qrow0+(wid>>1); const int na_qc=32*(wid&1)+r32; na_off=15-na_qc+4*hi; { int a_=na_qr-4; a_=a_<0?0:a_; const int m_=nrows-8; na_rsw=a_>m_?m_:a_; } \
    { int c_=na_qc-8; c_=c_<0?0:c_; c_=c_>48?48:c_; _Pragma("unroll") for(int r=0;r<16;++r){ const int kc_=(r&3)+8*(r>>2)+4*hi; na_mw|=(((unsigned)(kc_-c_)<16u)?1u:0u)<<r; na_mw|=(((unsigned)(kc_+32-c_)<16u)?1u:0u)<<(16+r); } } \
    if(tid<465)((__attribute__((address_space(3))) float*)((__attribute__((address_space(3))) char*)shm+NA_TBL_OFF))[tid]=rpbh[tid]*1.4426950408889634f; }
#define NA_LD(D,W,R4) do{ _Pragma("unroll") for(int i_=0;i_<4;++i_) D[i_]=tp_[(((R4)+i_)&3)+8*(((R4)+i_)>>2)+32*(W)]; }while(0)
#define NA_CP(S_,P,W,R4) do{ _Pragma("unroll") for(int i_=0;i_<4;++i_){ unsigned m_; asm("v_bfe_i32 %0, %1, %2, 1":"=v"(m_):"v"(mw_),"n"(16*(W)+(R4)+i_)); const float x_=P[(R4)+i_]+(S_[i_]-mhat); P[(R4)+i_]=__uint_as_float((__float_as_uint(x_)&m_)|(0xFF800000u&~m_)); } }while(0)
#define NAMASK(P0,P1,t) do{ if constexpr(NA){ const int kr_=b0+(t); f32x16&P0_=P0; f32x16&P1_=P1; \
   if(kr_>=na_rsw && kr_<na_rsw+8){ const na_lptr tp_=na_tbl+((kr_-na_qr+7)*31+na_off); unsigned mw_=na_mw; asm volatile("":"+v"(mw_)); float ga_[4],gb_[4]; \
     if((wid&1)==0){ \
       NA_LD(ga_,0,0); NA_LD(gb_,0,4); SBAR(); NA_CP(ga_,P0_,0,0); NA_LD(ga_,0,8); SBAR(); NA_CP(gb_,P0_,0,4); NA_LD(gb_,0,12); SBAR(); \
       NA_CP(ga_,P0_,0,8); NA_LD(ga_,1,0); SBAR(); NA_CP(gb_,P0_,0,12); SBAR(); NA_CP(ga_,P1_,1,0); \
       _Pragma("unroll") for(int r=4;r<16;++r)P1_[r]=-INFINITY; \
     } else { \
       NA_LD(ga_,0,12); NA_LD(gb_,1,0); SBAR(); NA_CP(ga_,P0_,0,12); NA_LD(ga_,1,4); SBAR(); NA_CP(gb_,P1_,1,0); NA_LD(gb_,1,8); SBAR(); \
       NA_CP(ga_,P1_,1,4); NA_LD(ga_,1,12); SBAR(); NA_CP(gb_,P1_,1,8); SBAR(); NA_CP(ga_,P1_,1,12); \
       _Pragma("unroll") for(int r=0;r<12;++r)P0_[r]=-INFINITY; \
     } } \
   else { _Pragma("unroll") for(int r=0;r<16;++r){P0_[r]=-INFINITY;P1_[r]=-INFINITY;} } } }while(0)
constexpr int NSLOT=3, SLOTB=8192;
constexpr int LDS_K=0, LDS_V=NSLOT*SLOTB, LDS_WS=2*NSLOT*SLOTB, LDS_OST=LDS_WS+NW*64*4, LDS_BYTES=LDS_OST+NW*4096;
constexpr float C2=0.125f*1.4426950408889634f;
__device__ __forceinline__ void glds16(const void*gsrc,unsigned lds_dst){unsigned keep;
  asm volatile("s_mov_b32 %0, m0\n\ts_mov_b32 m0, %2\n\ts_nop 0\n\tglobal_load_lds_dwordx4 %1, off\n\ts_mov_b32 m0, %0":"=&s"(keep):"v"(gsrc),"s"(lds_dst):"memory");}
__device__ __forceinline__ float max3f(float a,float b,float c){float r;asm("v_max3_f32 %0, %1, %2, %3":"=v"(r):"v"(a),"v"(b),"v"(c));return r;}
__device__ __forceinline__ float max2f(float a,float b){float r;asm("v_max_f32_e32 %0, %1, %2":"=v"(r):"v"(a),"v"(b));return r;}
__device__ __forceinline__ float fadd_s(float a,float b){float r;asm("v_add_f32_e32 %0, %1, %2":"=v"(r):"v"(a),"v"(b));return r;}
__device__ __forceinline__ float fsub_s(float a,float b){float r;asm("v_sub_f32_e32 %0, %1, %2":"=v"(r):"v"(a),"v"(b));return r;}
typedef float f32x2_t __attribute__((ext_vector_type(2))); typedef __bf16 bf16x2_t __attribute__((ext_vector_type(2)));
__device__ __forceinline__ unsigned cvtpk_s(float lo,float hi){f32x2_t v={lo,hi};bf16x2_t b=__builtin_convertvector(v,bf16x2_t);return __builtin_bit_cast(unsigned,b);}
#define WAIT_BAR(N) asm volatile("s_waitcnt vmcnt(" #N ") lgkmcnt(0)\n\ts_barrier":::"memory")

__device__ __forceinline__ void qkt(f32x16&p0,f32x16&p1,const char*Kslot,const bf16x8*qr,const f32x16&negm,int r32,int hi){
  const char*kb=Kslot+hi*1024+r32*16;
  #pragma unroll
  for(int d0=0;d0<4;++d0){
    const bf16x8 b0=*reinterpret_cast<const bf16x8*>(kb+d0*2048);
    const bf16x8 b1=*reinterpret_cast<const bf16x8*>(kb+d0*2048+512);
    if(d0==0){p0=__builtin_amdgcn_mfma_f32_32x32x16_bf16(b0,qr[0],negm,0,0,0);p1=__builtin_amdgcn_mfma_f32_32x32x16_bf16(b1,qr[0],negm,0,0,0);}
    else{p0=__builtin_amdgcn_mfma_f32_32x32x16_bf16(b0,qr[d0],p0,0,0,0);p1=__builtin_amdgcn_mfma_f32_32x32x16_bf16(b1,qr[d0],p1,0,0,0);}}
}
typedef __attribute__((address_space(3))) const char* lds_cptr;
typedef short v4i16_t __attribute__((ext_vector_type(4)));
__device__ __forceinline__ void kload8(bf16x8*kf,lds_cptr kp){
  kf[0]=*(const __attribute__((address_space(3))) bf16x8*)(kp);      kf[1]=*(const __attribute__((address_space(3))) bf16x8*)(kp+512);
  kf[2]=*(const __attribute__((address_space(3))) bf16x8*)(kp+2048); kf[3]=*(const __attribute__((address_space(3))) bf16x8*)(kp+2560);
  kf[4]=*(const __attribute__((address_space(3))) bf16x8*)(kp+4096); kf[5]=*(const __attribute__((address_space(3))) bf16x8*)(kp+4608);
  kf[6]=*(const __attribute__((address_space(3))) bf16x8*)(kp+6144); kf[7]=*(const __attribute__((address_space(3))) bf16x8*)(kp+6656);
}
__device__ __forceinline__ void kload2(bf16x8*kf,lds_cptr kp,int j){ kf[2*j]=*(const __attribute__((address_space(3))) bf16x8*)(kp+j*2048); kf[2*j+1]=*(const __attribute__((address_space(3))) bf16x8*)(kp+j*2048+512); }
__device__ __forceinline__ s16x4 vtr(lds_cptr p){ return __builtin_bit_cast(s16x4,__builtin_amdgcn_ds_read_tr16_b64_v4i16((__attribute__((address_space(3))) v4i16_t*)p)); }
__device__ __forceinline__ float rowmax(const f32x16&p0,const f32x16&p1){
  float a=max3f(p0[0],p0[1],p1[0]),b=max3f(p0[2],p0[3],p1[1]);a=max3f(a,p1[2],p1[3]);
  #pragma unroll
  for(int r=4;r<16;r+=4){a=max3f(a,p0[r],p0[r+1]);b=max3f(b,p0[r+2],p0[r+3]);a=max3f(a,p1[r],p1[r+1]);b=max3f(b,p1[r+2],p1[r+3]);}
  const float m=max2f(a,b);
  auto rr=__builtin_amdgcn_permlane32_swap(__float_as_uint(m),__float_as_uint(m),false,false);
  return max2f(__uint_as_float(rr[0]),__uint_as_float(rr[1]));
}
__device__ __forceinline__ void pv(f32x16*o,int vb,bf16x8 pa0,bf16x8 pa1,bf16x8 pa2,bf16x8 pa3){
  #pragma unroll
  for(int d0=0;d0<2;++d0){s16x4 lo[4],hi[4];
    #pragma unroll
    for(int ks=0;ks<4;++ks){
      asm volatile("ds_read_b64_tr_b16 %0,%1 offset:%c2":"=&v"(lo[ks]):"v"(vb),"i"(d0*4096+ks*1024):"memory");
      asm volatile("ds_read_b64_tr_b16 %0,%1 offset:%c2":"=&v"(hi[ks]):"v"(vb),"i"(d0*4096+ks*1024+512):"memory");}
    asm volatile("s_waitcnt lgkmcnt(0)":::"memory");SBAR();
    #define PK(k) (bf16x8){lo[k][0],lo[k][1],lo[k][2],lo[k][3],hi[k][0],hi[k][1],hi[k][2],hi[k][3]}
    o[d0]=__builtin_amdgcn_mfma_f32_32x32x16_bf16(pa0,PK(0),o[d0],0,0,0);
    o[d0]=__builtin_amdgcn_mfma_f32_32x32x16_bf16(pa1,PK(1),o[d0],0,0,0);
    o[d0]=__builtin_amdgcn_mfma_f32_32x32x16_bf16(pa2,PK(2),o[d0],0,0,0);
    o[d0]=__builtin_amdgcn_mfma_f32_32x32x16_bf16(pa3,PK(3),o[d0],0,0,0);
    #undef PK
  }
}

template<int THRL,bool NA> __device__ __forceinline__ int attn_unit(const bf16*Qu,bf16*Ou,int qp,const bf16*__restrict__ Kh,const bf16*__restrict__ Vh,int kp,int NT,char*shm,
    const float*__restrict__ rpbh,int b0,int qrow0,int nrows,const int wave_s,const int s0b,const bool pre,const bf16*__restrict__ nKh,const bf16*__restrict__ nVh){
  int tid_=(wave_s<<6)|lane_now(); asm volatile("":"+v"(tid_)); const int tid=tid_,lane=tid&63,r32=lane&31,hi=lane>>5; const int wid=__builtin_amdgcn_readfirstlane(tid>>6);
  const bf16*Qw=Qu+(long)(wid*QBLK)*qp;
  const unsigned lds0=(unsigned)(uintptr_t)shm;
  float*wsf=(float*)(shm+LDS_WS)+wid*64;
  const bf16*ksrc=Kh+(long)lane*kp+wid*8;
  const bf16*vsrc=Vh+(long)(16*(wid&3)+(lane>>2))*kp+(wid>>2)*32+(lane&3)*8;
  const unsigned kdst=lds0+LDS_K+wid*1024, vdst=lds0+LDS_V+wid*1024;
  #define DMA_K(t,slot) glds16(ksrc+(long)(t)*KVBLK*kp,(unsigned)__builtin_amdgcn_readfirstlane(kdst+(slot)))
  #define DMA_V(t,slot) glds16(vsrc+(long)(t)*KVBLK*kp,(unsigned)__builtin_amdgcn_readfirstlane(vdst+(slot)))
  const int vb0=(int)(lds0+LDS_V)+((lane>>4)&1)*32+(lane&3)*8+(4*hi+((lane&15)>>2))*64;
  const char*Kbase=shm+LDS_K; bf16x8 kf[8];
  const lds_cptr shm3=(lds_cptr)shm; const lds_cptr kp0=shm3+LDS_K+hi*1024+r32*16; const lds_cptr vp0=shm3+LDS_V+((lane>>4)&1)*32+(lane&3)*8+(4*hi+((lane&15)>>2))*64;
  #define NXS(x) (((x)==(NSLOT-1)*SLOTB)?0:(x)+SLOTB)
  const int s1b=NXS(s0b),s2b=NXS(s1b);
  if(!pre){DMA_K(0,s0b);DMA_V(0,s0b);DMA_K(1,s1b);}
  bf16x8 qr[4];
  #pragma unroll
  for(int d0=0;d0<4;++d0)qr[d0]=*reinterpret_cast<const bf16x8*>(&Qw[(long)r32*qp+d0*16+hi*8]);
  float mhat=0.f,l_reg=0.f;f32x16 o[2];o[0]=f32x16{};o[1]=f32x16{};f32x16 negm=f32x16{};if constexpr(!NA&&THRL>=0){asm volatile("":"+v"(negm));}
  NA_SETUP
  #define NEGMC ((NA||THRL<0)?f32x16{}:negm)
  #define CMASK(P0,P1,t) NAMASK(P0,P1,t)
  bool resc=false;
  #define START(P0,P1) do{ resc=false; \
    if constexpr(THRL>=0){ const float rm=rowmax(P0,P1); const float dl=NA?__builtin_fmaxf(rm,-1000.f):rm; mhat=fadd_s(mhat,dl); \
      _Pragma("unroll") for(int r=0;r<16;++r){P0[r]=fsub_s(P0[r],dl);P1[r]=fsub_s(P1[r],dl);} \
      if constexpr(!NA){_Pragma("unroll") for(int r=0;r<16;++r)negm[r]=-mhat; asm volatile("":"+v"(negm));} } \
    _Pragma("unroll") for(int r=0;r<16;++r)P0[r]=__builtin_amdgcn_exp2f(P0[r]); }while(0)
  #define RESC() do{ if(resc){ asm volatile("s_waitcnt lgkmcnt(0)":::"memory"); \
      _Pragma("unroll") for(int d_=0;d_<2;++d_) _Pragma("unroll") for(int r=0;r<16;++r)o[d_][r]*=wsf[crow(r,hi)]; } }while(0)
  f32x16 pA0,pA1,pB0,pB1;
  int sl_prev=s0b,sl_cur=s0b,sl_next=s1b;
  #define ROT() do{sl_prev=sl_cur;sl_cur=sl_next;sl_next=(sl_next==(NSLOT-1)*SLOTB)?0:sl_next+SLOTB;}while(0)
  if(!pre){DMA_K(2,s2b);}
  WAIT_BAR(3);
  if constexpr(NA||THRL<0){const f32x16 z_=f32x16{};qkt(pA0,pA1,Kbase+s0b,qr,z_,r32,hi);}else{qkt(pA0,pA1,Kbase+s0b,qr,negm,r32,hi);}asm volatile("s_nop 15\n\ts_nop 7":"+v"(pA0),"+v"(pA1));CMASK(pA0,pA1,0);
  START(pA0,pA1);
  _Pragma("unroll") for(int r=0;r<16;++r)pA1[r]=__builtin_amdgcn_exp2f(pA1[r]);
  WAIT_BAR(0);
  DMA_K(3,s0b);DMA_V(1,s1b);
  ROT();
  kload8(kf,kp0+sl_cur);
  WAIT_BAR(2);
  s16x4 vlo[8],vhi[8]; u32x4 pw0,pw1,pw2,pw3;
  #define PKW(P,B) cvtpk_s(P[B],P[B+1])
  #define PAF(k) __builtin_bit_cast(bf16x8,pw##k)
  #define VFR(i) (bf16x8){vlo[i][0],vlo[i][1],vlo[i][2],vlo[i][3],vhi[i][0],vhi[i][1],vhi[i][2],vhi[i][3]}
  #define PIN(x) asm volatile("":"+v"(x))
  #define MX3(a,b,c) __builtin_fmaxf(__builtin_fmaxf((a),(b)),(c))
  #define GAPA(MF,A0,A1,A2,A3,W0,W1,PW) do{ MF; sacc+=A0; sacc+=A1; sacc+=A2; sacc+=A3; PIN(sacc); W0; W1; PIN(PW); SBAR(); }while(0)
  #define EX(v) __builtin_amdgcn_exp2f(v)
  #define GAPB(MF,X,B) do{ MF; X[B]=EX(X[B]); X[B+1]=EX(X[B+1]); X[B+2]=EX(X[B+2]); X[B+3]=EX(X[B+3]); PIN(X); SBAR(); }while(0)
  #define VRD(i) do{ vlo[i]=vtr(vp_+(((i)>>2)*4096+((i)&3)*1024)); vhi[i]=vtr(vp_+(((i)>>2)*4096+((i)&3)*1024+512)); }while(0)
  #define KRD(G,j) do{ if(G){ kload2(kf,kp0+sl_next,j); SBAR(); } }while(0)
  #define STEP(C0,C1,P0,P1,t,GK,GV,GL) do{ SBAR(); \
    const lds_cptr vp_=vp0+sl_prev; \
    VRD(0); SBAR(); float sacc=(P0[0]+P0[1]); \
    GAPA(C0=__builtin_amdgcn_mfma_f32_32x32x16_bf16(kf[0],qr[0],NEGMC,0,0,0), P0[2],P0[3],P0[4],P0[5],     pw0[0]=PKW(P0,0), pw0[1]=PKW(P0,2), pw0); \
    VRD(4); SBAR(); GAPA(C1=__builtin_amdgcn_mfma_f32_32x32x16_bf16(kf[1],qr[0],NEGMC,0,0,0), P0[6],P0[7],P0[8],P0[9],     pw0[2]=PKW(P0,4), pw0[3]=PKW(P0,6), pw0); \
    VRD(1); SBAR(); GAPA(C0=__builtin_amdgcn_mfma_f32_32x32x16_bf16(kf[2],qr[1],C0,0,0,0),   P0[10],P0[11],P0[12],P0[13], pw1[0]=PKW(P0,8), pw1[1]=PKW(P0,10), pw1); \
    VRD(5); SBAR(); GAPA(C1=__builtin_amdgcn_mfma_f32_32x32x16_bf16(kf[3],qr[1],C1,0,0,0),   P0[14],P0[15],P1[0],P1[1],   pw1[2]=PKW(P0,12),pw1[3]=PKW(P0,14), pw1); \
    VRD(2); SBAR(); GAPA(C0=__builtin_amdgcn_mfma_f32_32x32x16_bf16(kf[4],qr[2],C0,0,0,0),   P1[2],P1[3],P1[4],P1[5],     pw2[0]=PKW(P1,0), pw2[1]=PKW(P1,2), pw2); \
    VRD(6); SBAR(); GAPA(C1=__builtin_amdgcn_mfma_f32_32x32x16_bf16(kf[5],qr[2],C1,0,0,0),   P1[6],P1[7],P1[8],P1[9],     pw2[2]=PKW(P1,4), pw2[3]=PKW(P1,6), pw2); \
    VRD(3); SBAR(); GAPA(C0=__builtin_amdgcn_mfma_f32_32x32x16_bf16(kf[6],qr[3],C0,0,0,0),   P1[10],P1[11],P1[12],P1[13], pw3[0]=PKW(P1,8), pw3[1]=PKW(P1,10), pw3); \
    VRD(7); SBAR(); GAPA(C1=__builtin_amdgcn_mfma_f32_32x32x16_bf16(kf[7],qr[3],C1,0,0,0),   P1[14],P1[15],0.f,0.f,       pw3[2]=PKW(P1,12),pw3[3]=PKW(P1,14), pw3); \
    l_reg+=sacc; \
    if(GK){DMA_K((t)+3,sl_cur);} if(GV){DMA_V((t)+1,sl_next);} \
    CMASK(C0,C1,t); \
    resc=false; if constexpr(THRL>=0){ float a=MX3(C0[0],C0[1],C1[0]),b=MX3(C0[2],C0[3],C1[1]); a=MX3(a,C1[2],C1[3]); \
      _Pragma("unroll") for(int r=4;r<16;r+=4){a=MX3(a,C0[r],C0[r+1]);b=MX3(b,C0[r+2],C0[r+3]);a=MX3(a,C1[r],C1[r+1]);b=MX3(b,C1[r+2],C1[r+3]);} \
      float rm=__builtin_fmaxf(a,b); { auto rr=__builtin_amdgcn_permlane32_swap(__float_as_uint(rm),__float_as_uint(rm),false,false); rm=__builtin_fmaxf(__uint_as_float(rr[0]),__uint_as_float(rr[1])); } \
      resc=false; \
      if(__builtin_expect(__any(rm>(float)THRL),0)){ const float dl=__builtin_fmaxf(rm,0.f); mhat+=dl; \
        _Pragma("unroll") for(int r=0;r<16;++r){C0[r]-=dl;C1[r]-=dl;} \
        if constexpr(!NA){_Pragma("unroll") for(int r=0;r<16;++r)negm[r]=-mhat; asm volatile("":"+v"(negm));} \
        const float f=__builtin_amdgcn_exp2f(-dl); l_reg*=f; { const int l_=lane_now(); if(l_<32)wsf[l_]=f; } resc=true; } } \
    SBAR(); \
    GAPB(o[0]=__builtin_amdgcn_mfma_f32_32x32x16_bf16(PAF(0),VFR(0),o[0],0,0,0), C0,0); \
    GAPB(o[1]=__builtin_amdgcn_mfma_f32_32x32x16_bf16(PAF(0),VFR(4),o[1],0,0,0), C0,4); \
    KRD(GL,0); GAPB(o[0]=__builtin_amdgcn_mfma_f32_32x32x16_bf16(PAF(1),VFR(1),o[0],0,0,0), C0,8); \
    KRD(GL,1); GAPB(o[1]=__builtin_amdgcn_mfma_f32_32x32x16_bf16(PAF(1),VFR(5),o[1],0,0,0), C0,12); \
    KRD(GL,2); GAPB(o[0]=__builtin_amdgcn_mfma_f32_32x32x16_bf16(PAF(2),VFR(2),o[0],0,0,0), C1,0); \
    KRD(GL,3); GAPB(o[1]=__builtin_amdgcn_mfma_f32_32x32x16_bf16(PAF(2),VFR(6),o[1],0,0,0), C1,4); \
    GAPB(o[0]=__builtin_amdgcn_mfma_f32_32x32x16_bf16(PAF(3),VFR(3),o[0],0,0,0), C1,8); \
    GAPB(o[1]=__builtin_amdgcn_mfma_f32_32x32x16_bf16(PAF(3),VFR(7),o[1],0,0,0), C1,12); \
    }while(0)
  int t=1;
  for(;t+5<NT;t+=2){
    STEP(pB0,pB1,pA0,pA1,t,true,true,true);     WAIT_BAR(2); RESC(); ROT();
    STEP(pA0,pA1,pB0,pB1,t+1,true,true,true);   WAIT_BAR(2); RESC(); ROT();
  }
  #define ENDW(tt) do{ if((tt)+3<NT){WAIT_BAR(2);} else if((tt)+2<NT){WAIT_BAR(1);} else {WAIT_BAR(0);} }while(0)
  for(;t+1<NT;t+=2){
    STEP(pB0,pB1,pA0,pA1,t,(t+3<NT),(t+1<NT),(t+1<NT));       ENDW(t);   RESC(); ROT();
    STEP(pA0,pA1,pB0,pB1,t+1,(t+4<NT),(t+2<NT),(t+2<NT));     ENDW(t+1); RESC(); ROT();
  }
  STEP(pB0,pB1,pA0,pA1,NT-1,false,false,false); RESC();
  if(nKh){ const bf16*nks=nKh+(long)lane*kp+wid*8; const bf16*nvs=nVh+(long)(16*(wid&3)+(lane>>2))*kp+(wid>>2)*32+(lane&3)*8; const int n1=NXS(sl_next),n2=NXS(n1);
    glds16(nks,(unsigned)__builtin_amdgcn_readfirstlane(kdst+sl_next)); glds16(nvs,(unsigned)__builtin_amdgcn_readfirstlane(vdst+sl_next));
    glds16(nks+(long)KVBLK*kp,(unsigned)__builtin_amdgcn_readfirstlane(kdst+n1)); glds16(nks+(long)2*KVBLK*kp,(unsigned)__builtin_amdgcn_readfirstlane(kdst+n2)); }
  { float sacc=pB0[0]+pB0[1]; _Pragma("unroll") for(int r=2;r<16;++r)sacc+=pB0[r]; _Pragma("unroll") for(int r=0;r<16;++r)sacc+=pB1[r]; l_reg+=sacc;
    pw0=(u32x4){PKW(pB0,0),PKW(pB0,2),PKW(pB0,4),PKW(pB0,6)};pw1=(u32x4){PKW(pB0,8),PKW(pB0,10),PKW(pB0,12),PKW(pB0,14)};pw2=(u32x4){PKW(pB1,0),PKW(pB1,2),PKW(pB1,4),PKW(pB1,6)};pw3=(u32x4){PKW(pB1,8),PKW(pB1,10),PKW(pB1,12),PKW(pB1,14)};
    SBAR(); pv(o,vb0+sl_cur,PAF(0),PAF(1),PAF(2),PAF(3)); }
  #undef PKW
  #undef PAF
  #undef VFR
  #undef PIN
  #undef MX3
  #undef GAPA
  #undef GAPB
  #undef EX
  #undef VRD
  #undef KRD
  #undef STEP
  #undef ENDW
  {auto rr=__builtin_amdgcn_permlane32_swap(__float_as_uint(l_reg),__float_as_uint(l_reg),false,false);l_reg=__uint_as_float(rr[0])+__uint_as_float(rr[1]);}
  if(hi==0)wsf[32+r32]=l_reg;asm volatile("s_waitcnt lgkmcnt(0)":::"memory");
  float rli[16];
  #pragma unroll
  for(int r=0;r<16;++r)rli[r]=__builtin_amdgcn_rcpf(wsf[32+crow(r,hi)]);
  bf16*Ow=Ou+(long)(wid*QBLK)*qp;
  { bf16*stg=(bf16*)(shm+LDS_OST)+wid*2048;
    #pragma unroll
    for(int r=0;r<16;++r){const int orow=crow(r,hi);
      #pragma unroll
      for(int d0=0;d0<2;++d0)stg[orow*64+d0*32+r32]=__float2bfloat16(o[d0][r]*rli[r]);}
    asm volatile("s_waitcnt lgkmcnt(0)":::"memory");
    { const __amdgpu_buffer_rsrc_t orsrc=__builtin_amdgcn_make_buffer_rsrc((void*)Ow,(short)0,32*qp*2,0x00020000);
    #pragma unroll
    for(int i=0;i<4;++i){const int row=i*8+(lane>>3),ch=lane&7; const u32x4 v=*(const u32x4*)(stg+row*64+ch*8); __builtin_amdgcn_raw_buffer_store_b128(v,orsrc,(unsigned)((row*qp+ch*8)*2),0,16);} } }
  asm volatile("s_waitcnt lgkmcnt(0)\n\ts_barrier":::"memory");
  const int ret_slot=sl_next;
  #undef NXS
  #undef DMA_K
  #undef DMA_V
  #undef CMASK
  #undef START
  #undef RESC
  #undef ROT
  return ret_slot;
}
struct NaUnit { size_t qoff, koff; int lo, nt, h, qb, rows; bool ok; };
__device__ __forceinline__ NaUnit na_unit_of(int li, int vcu, int perP, int perS, int nP, int nS) {
  NaUnit u; u.ok = false; u.qoff = 0; u.koff = 0; u.lo = 0; u.nt = 0; u.h = 0; u.qb = 0; u.rows = 0;
  if (li >= perP + perS) return u;
  const bool isP = li < perP; const int idx = isP ? vcu * perP + li : vcu * perS + (li - perP);
  if (idx >= (isP ? nP : nS)) return u;
  const int nqb = isP ? 16 : 8, rows = isP ? 64 : 32, S = rows * 64; const int bh = idx / nqb, qb = idx % nqb, b = bh >> 3, h = bh & 7;
  const size_t rb = (isP ? (size_t)0 : (size_t)(8 * 4096)) + (size_t)b * S;
  int lo = 4 * qb - 4; lo = lo < 0 ? 0 : lo; lo = lo > rows - 8 ? rows - 8 : lo; int hi_ = 4 * qb - 1; hi_ = hi_ < 0 ? 0 : hi_; hi_ = hi_ > rows - 8 ? rows - 8 : hi_; hi_ += 8;
  int nt = hi_ - lo; nt += nt & 1; if (lo + nt > rows) lo = rows - nt;
  u.ok = true; u.qoff = (rb + (size_t)qb * 256) * 1024 + 512 + h * 64; u.koff = (rb + (size_t)lo * 64) * 512 + h * 64; u.lo = lo; u.nt = nt; u.h = h; u.qb = qb; u.rows = rows;
  return u;
}
constexpr int ATTN_LDS_BYTES=LDS_BYTES;
#undef SBAR
#undef WAIT_BAR
#undef NA_SETUP
#undef NAMASK
#undef NA_LD
#undef NA_CP
}

#ifndef PROBE_DUP
#define PROBE_DUP 0
#endif
#ifndef PH_MASK
#define PH_MASK 255
#endif
constexpr int NWAVES = 8;
constexpr int DMODEL = 1024, MP = 8 * 4096, MS = 32 * 2048, MTOK = MP + MS, NIN = 4352, FF = 4096;
constexpr size_t MiB = 1u << 20;
constexpr size_t WS_SS = 0, WS_SS2 = 1 * MiB, WS_ROPE = 2 * MiB, WS_BAR = 3 * MiB;
constexpr int MISC_OFF = 131072 + 320;
constexpr size_t WS_WIN = 4 * MiB, WS_WP = 13 * MiB, WS_WO = 15 * MiB, WS_WUP = 17 * MiB, WS_WDN = 25 * MiB;
constexpr size_t WS_QAB = 40 * MiB, WS_KAVA = 232 * MiB, WS_KB = 280 * MiB, WS_VB = 376 * MiB, WS_G = 472 * MiB, WS_U = 232 * MiB, WS_MG = 280 * MiB, WS_HB = 40 * MiB, WS_END = 1000 * MiB;
static_assert(WS_WIN + (size_t)NIN * 1024 * 2 <= WS_WP && WS_WDN + (size_t)FF * 1024 * 2 <= WS_QAB, "weights map");
static_assert(WS_QAB + (size_t)MTOK * 1024 * 2 == WS_KAVA && WS_KAVA + (size_t)MTOK * 256 * 2 == WS_KB && WS_KB + (size_t)MTOK * 512 * 2 == WS_VB && WS_VB + (size_t)MTOK * 512 * 2 == WS_G, "activation map");
static_assert(WS_G + (size_t)MTOK * 2048 * 2 <= WS_END && WS_U + (size_t)MTOK * 4096 * 2 <= WS_END, "ws end");
constexpr int LDS_BYTES = 147456;

#define GAS __attribute__((address_space(1)))
#define LAS __attribute__((address_space(3)))
typedef unsigned short bf16;
typedef unsigned v4u __attribute__((ext_vector_type(4)));
typedef float f32x4 __attribute__((ext_vector_type(4)));
#define LDS_WAIT() asm volatile("s_waitcnt lgkmcnt(0)" ::: "memory")
typedef GAS unsigned gu32;
#define RLX_AGENT __ATOMIC_RELAXED, __HIP_MEMORY_SCOPE_AGENT
#define XB_TMO      128
#define XB_XCNT(j)  (256  + 64 * (j))
#define XB_XSUB(j)  (1280 + 64 * (j))
#define XB_XGEN(j)  (2304 + 64 * (j))
#define XB_TOP      3328
#define XB_TOPGEN   3392
#define XCD_BAR_WORDS 3456
#define XB_SPIN_CAP (1u << 18)

__device__ __forceinline__ unsigned xb_ld(unsigned* p)              { return __hip_atomic_load(p, __ATOMIC_RELAXED, __HIP_MEMORY_SCOPE_AGENT); }
__device__ __forceinline__ unsigned xb_add(unsigned* p, unsigned v) { return __hip_atomic_fetch_add(p, v, __ATOMIC_RELAXED, __HIP_MEMORY_SCOPE_AGENT); }
__device__ __forceinline__ unsigned xb_xcc_id() { return (unsigned)__builtin_amdgcn_s_getreg((3 << 11) | 20) & 0xFu; }
#define XB_SPIN(cond, bar) do { unsigned _sp = 0; while (cond) { __builtin_amdgcn_s_sleep(1); \
    if ((++_sp & 255u) == 0u) { if (xb_ld(&(bar)[XB_TMO])) break; if (_sp > XB_SPIN_CAP) { atomicAdd(&(bar)[XB_TMO], 1u); break; } } } } while (0)

struct XcdBarrier {
    unsigned* bar; unsigned x; int wave;
    volatile LAS unsigned* st;
};

__device__ __forceinline__ XcdBarrier xcd_barrier_post(unsigned* bar, volatile LAS unsigned* st, int wave) {
    XcdBarrier b; b.bar = bar; b.x = xb_xcc_id(); b.st = st; b.wave = wave;
    if (wave == 0 && lane_now() == 0) (void)xb_add(&bar[XB_XCNT(b.x)], 1u);
    return b;
}
__device__ __forceinline__ void xcd_barrier_complete(unsigned* bar, unsigned x, unsigned& nloc, unsigned& nx) {
    const unsigned G = gridDim.x * gridDim.y * gridDim.z;
    unsigned sum, cnt, mine, sp = 0u;
    for (;;) {
        sum = 0u; cnt = 0u; mine = 0u;
#pragma unroll
        for (unsigned j = 0; j < 16; ++j) { const unsigned c = xb_ld(&bar[XB_XCNT(j)]); sum += c; cnt += (c > 0u) ? 1u : 0u; mine = (j == x) ? c : mine; }
        if (sum == G) break;
        __builtin_amdgcn_s_sleep(1);
        if ((++sp & 255u) == 0u) { if (xb_ld(&bar[XB_TMO])) break; if (sp > XB_SPIN_CAP) { atomicAdd(&bar[XB_TMO], 1u); break; } }
    }
    nloc = mine > 0u ? mine : 1u; nx = cnt > 0u ? cnt : 1u;
}

__device__ __forceinline__ void xcd_barrier(const XcdBarrier& b) {
    asm volatile("s_waitcnt vmcnt(0)" ::: "memory");
    __syncthreads();
    if (b.wave == 0 && lane_now() == 0) {
        unsigned* bar = b.bar;
        __builtin_amdgcn_s_waitcnt(0);
        unsigned nloc = b.st[0], nx = b.st[1];
        if (nloc == 0u) { xcd_barrier_complete(bar, b.x, nloc, nx); b.st[0] = nloc; b.st[1] = nx; }
        const unsigned old = xb_add(&bar[XB_XSUB(b.x)], 1u);
        const unsigned gen = old / nloc;
        if (old + 1u == (gen + 1u) * nloc) {
            __builtin_amdgcn_fence(__ATOMIC_RELEASE, "agent");
            asm volatile("s_waitcnt vmcnt(0)" ::: "memory");
            const unsigned og = xb_add(&bar[XB_TOP], 1u);
            const unsigned tg = og / nx;
            if (og + 1u == (tg + 1u) * nx) xb_add(&bar[XB_TOPGEN], 1u);
            else XB_SPIN(xb_ld(&bar[XB_TOPGEN]) == tg, bar);
            __builtin_amdgcn_fence(__ATOMIC_ACQUIRE, "agent");
            xb_add(&bar[XB_XGEN(b.x)], 1u);
            asm volatile("s_waitcnt vmcnt(0)" ::: "memory");
        } else {
            XB_SPIN(xb_ld(&bar[XB_XGEN(b.x)]) == gen, bar);
            __builtin_amdgcn_fence(__ATOMIC_ACQUIRE, "agent");
            asm volatile("s_waitcnt vmcnt(0)" ::: "memory");
        }
    }
    __syncthreads();
}

__device__ __forceinline__ float wave_sum(float v) {
#pragma unroll
    for (int o = 1; o < 64; o <<= 1) v += __shfl_xor(v, o);
    return v;
}
__device__ __forceinline__ void tr_item(const float* W, int N, int k0, int n0, bf16* WT, int ldt, int drow0, int dk0, const float* kscale, LAS float* scr, int lane) {
    float wv[32];
#pragma unroll
    for (int i = 0; i < 32; ++i) { const int kk = 2 * i + (lane >> 5); wv[i] = W[(size_t)(k0 + kk) * N + n0 + (lane & 31)]; }
#pragma unroll
    for (int i = 0; i < 32; ++i) { const int kk = 2 * i + (lane >> 5); float w = wv[i]; if (kscale) w *= kscale[k0 + kk]; scr[kk * 33 + (lane & 31)] = w; }
    LDS_WAIT(); asm volatile("" ::: "memory");
    const int c = lane & 7;
#pragma unroll
    for (int j = 0; j < 4; ++j) { const int n = (lane >> 3) + 8 * j; const LAS float* s = scr + (8 * c) * 33 + n;
        v4u o; o.x = pg8::pkbf(s[0 * 33], s[1 * 33]); o.y = pg8::pkbf(s[2 * 33], s[3 * 33]); o.z = pg8::pkbf(s[4 * 33], s[5 * 33]); o.w = pg8::pkbf(s[6 * 33], s[7 * 33]);
        *(GAS v4u*)(WT + (size_t)(drow0 + n) * ldt + dk0 + 8 * c) = o; }
    LDS_WAIT(); asm volatile("" ::: "memory");
}
__device__ __forceinline__ void rms_row_to_bf16(const float* xrow, const float* g, bf16* orow, int lane) {
    const GAS f32x4* xr = (const GAS f32x4*)xrow + lane; const GAS f32x4* gr = (const GAS f32x4*)g + lane;
    f32x4 v[4]; float s = 0.f;
#pragma unroll
    for (int j = 0; j < 4; ++j) { v[j] = xr[64 * j]; s += pg8::sumsq4(v[j]); }
    const float rstd = __builtin_amdgcn_rsqf(wave_sum(s) * (1.f / 1024.f) + 1e-6f);
    GAS unsigned long long* o8 = (GAS unsigned long long*)orow + lane;
#pragma unroll
    for (int j = 0; j < 4; ++j) { const f32x4 gg = gr[64 * j]; const f32x4 y = v[j] * rstd * gg; o8[64 * j] = (unsigned long long)pg8::pkbf(y[0], y[1]) | ((unsigned long long)pg8::pkbf(y[2], y[3]) << 32); }
}
__device__ __forceinline__ void cvt_row2_to_bf16(const float* xa, const float* xb, bf16* oa, bf16* ob, float* sa_out, float* sb_out, int lane) {
    const GAS f32x4* ra = (const GAS f32x4*)xa + lane; const GAS f32x4* rb = (const GAS f32x4*)xb + lane;
    f32x4 va[4], vb[4]; float sa = 0.f, sb = 0.f;
#pragma unroll
    for (int j = 0; j < 4; ++j) { va[j] = __builtin_nontemporal_load(ra + 64 * j); vb[j] = __builtin_nontemporal_load(rb + 64 * j); }
    GAS unsigned long long* pa = (GAS unsigned long long*)oa + lane; GAS unsigned long long* pb = (GAS unsigned long long*)ob + lane;
#pragma unroll
    for (int j = 0; j < 4; ++j) { sa += pg8::sumsq4(va[j]); sb += pg8::sumsq4(vb[j]);
        pa[64 * j] = (unsigned long long)pg8::pkbf(va[j][0], va[j][1]) | ((unsigned long long)pg8::pkbf(va[j][2], va[j][3]) << 32);
        pb[64 * j] = (unsigned long long)pg8::pkbf(vb[j][0], vb[j][1]) | ((unsigned long long)pg8::pkbf(vb[j][2], vb[j][3]) << 32); }
#pragma unroll
    for (int o = 1; o < 64; o <<= 1) { sa += __shfl_xor(sa, o); sb += __shfl_xor(sb, o); }
    if (lane == 0) { *sa_out = sa; *sb_out = sb; }
}
__device__ __forceinline__ void final_row(const bf16* hrow, float* orow, const float* g, float ssum, int lane) {
    const float rs = __builtin_amdgcn_rsqf(ssum * (1.f / 1024.f) + 1e-6f);
#pragma unroll
    for (int j = 0; j < 2; ++j) { const v4u h = *((const GAS v4u*)hrow + lane + 64 * j); const int c = (lane + 64 * j) * 8;
        const f32x4 g0 = *(const GAS f32x4*)(g + c), g1 = *(const GAS f32x4*)(g + c + 4);
        f32x4 a, b; a[0] = pg8::bflo(h.x); a[1] = pg8::bfhi(h.x); a[2] = pg8::bflo(h.y); a[3] = pg8::bfhi(h.y); b[0] = pg8::bflo(h.z); b[1] = pg8::bfhi(h.z); b[2] = pg8::bflo(h.w); b[3] = pg8::bfhi(h.w);
        *(GAS f32x4*)(orow + c) = a * rs * g0; *(GAS f32x4*)(orow + c + 4) = b * rs * g1; }
}

struct Args { const float* in[14]; float* out; unsigned char* ws; unsigned long long never; };

__global__ void __launch_bounds__(NWAVES * 64, 2) fwd_kernel(Args args) {
    extern __shared__ __attribute__((aligned(16))) unsigned char lds[];
    cg::grid_group grid = cg::this_grid();
    LAS unsigned char* ldsp = (LAS unsigned char*)lds;
    const int wave = __builtin_amdgcn_readfirstlane((int)threadIdx.x >> 6);
    const int G = gridDim.x; const int bx = blockIdx.x; const int vcu = (G % 8 == 0) ? (bx % 8) * (G / 8) + bx / 8 : bx;
    unsigned char* ws = args.ws;
    float* ss = (float*)(ws + WS_SS); float* ss2 = (float*)(ws + WS_SS2); float* ssx = (float*)(ws + WS_SS2 + 512 * 1024); float* rope = (float*)(ws + WS_ROPE);
    bf16* Win_t = (bf16*)(ws + WS_WIN); bf16* Wp_t = (bf16*)(ws + WS_WP); bf16* Wo_t = (bf16*)(ws + WS_WO); bf16* Wup_t = (bf16*)(ws + WS_WUP); bf16* Wdn_t = (bf16*)(ws + WS_WDN);
    bf16* QAB = (bf16*)(ws + WS_QAB); bf16* KAVA = (bf16*)(ws + WS_KAVA); bf16* KB = (bf16*)(ws + WS_KB); bf16* VB = (bf16*)(ws + WS_VB); bf16* GT = (bf16*)(ws + WS_G);
    bf16* U = (bf16*)(ws + WS_U); bf16* MG = (bf16*)(ws + WS_MG); bf16* HB = (bf16*)(ws + WS_HB);
    float* out = args.out; bf16* XN = (bf16*)out;
    volatile LAS unsigned* MISC = (volatile LAS unsigned*)(ldsp + MISC_OFF);
    if (wave == 0 && lane_now() < 32) MISC[lane_now()] = 0u;
    __syncthreads();
    unsigned* barw = (unsigned*)(ws + WS_BAR);
    if (args.never != 0) grid.sync();
    const XcdBarrier xbar = xcd_barrier_post(barw, MISC + 8, wave);

#if PH_MASK & (1 << 0)
    {
        int tid = (wave << 6) | lane_now(); asm volatile("" : "+v"(tid)); const int lane = tid & 63;
        const int gw = vcu * NWAVES + wave, NGW = G * NWAVES;
        for (int i = bx * 512 + tid; i < MTOK; i += G * 512) { ss[i] = 0.f; ss2[i] = 0.f; }
        if (bx == 0 && tid < 16) {
            double th = 1.0; for (int j = 0; j < tid; ++j) th *= 0.5623413251903491;
            double c1 = 1.0, s1 = th, tc = 1.0, tsn = th; const double t2 = th * th;
            for (int k = 1; k < 14; ++k) { tc = -tc * t2 / (double)((2 * k - 1) * (2 * k)); tsn = -tsn * t2 / (double)((2 * k) * (2 * k + 1)); c1 += tc; s1 += tsn; }
            double c = 1.0, s = 0.0;
            for (int p = 0; p < 64; ++p) { rope[(p * 16 + tid) * 2] = (float)c; rope[(p * 16 + tid) * 2 + 1] = (float)s; const double cn = c * c1 - s * s1, sn = s * c1 + c * s1; c = cn; s = sn; }
        }
        LAS float* scr = (LAS float*)(ldsp + wave * 16384);
        constexpr int I_IN = 16 * (NIN / 32), I_PA = 8 * 32, I_PB = 8 * 32, I_O = 16 * 32, I_UP = 16 * (FF / 32), I_DN = 64 * 32;
        constexpr int NITEMS = I_IN + I_PA + I_PB + I_O + I_UP + I_DN;
        for (int it = gw; it < NITEMS; it += NGW) {
            int r = it;
            if (r < I_IN) { const int nb = r % (NIN / 32), kb = r / (NIN / 32); const int n0 = nb * 32; int d0 = n0;
                if (n0 < 768) { const int pn = n0 >> 8, rem = n0 & 255, wc = rem >> 6, bj = (rem & 63) >> 5; d0 = 256 * pn + 128 * bj + 32 * wc; }
                else if (n0 >= 2304) { const int isb = n0 >= 3328, c0 = n0 - (isb ? 3328 : 2304); d0 = 2304 + 256 * (c0 >> 7) + 128 * isb + (c0 & 127); }
                tr_item(args.in[3], NIN, kb * 64, n0, Win_t, 1024, d0, kb * 64, args.in[2], scr, lane); continue; } r -= I_IN;
            if (r < I_PA) { const int nb = r % 32, kb = r / 32; tr_item(args.in[7], 1024, kb * 64, nb * 32, Wp_t, 1024, nb * 32, kb * 64, nullptr, scr, lane); continue; } r -= I_PA;
            if (r < I_PB) { const int nb = r % 32, kb = r / 32; tr_item(args.in[8], 1024, kb * 64, nb * 32, Wp_t, 1024, nb * 32, 512 + kb * 64, nullptr, scr, lane); continue; } r -= I_PB;
            if (r < I_O) { const int nb = r % 32, kb = r / 32; tr_item(args.in[9], 1024, kb * 64, nb * 32, Wo_t, 1024, nb * 32, kb * 64, nullptr, scr, lane); continue; } r -= I_O;
            if (r < I_UP) { const int nb = r % (FF / 32), kb = r / (FF / 32); tr_item(args.in[11], FF, kb * 64, nb * 32, Wup_t, 1024, nb * 32, kb * 64, args.in[10], scr, lane); continue; } r -= I_UP;
            { const int nb = r % 32, kb = r / 32; tr_item(args.in[12], 1024, kb * 64, nb * 32, Wdn_t, FF, nb * 32, kb * 64, nullptr, scr, lane); }
        }
        for (int m = gw; m < MTOK; m += 2 * NGW) {
            const int m2 = m + NGW; const bool two = m2 < MTOK; const int mb = two ? m2 : m;
            const float* xa = m < MP ? args.in[0] + (size_t)m * 1024 : args.in[1] + (size_t)(m - MP) * 1024;
            const float* xb = mb < MP ? args.in[0] + (size_t)mb * 1024 : args.in[1] + (size_t)(mb - MP) * 1024;
            cvt_row2_to_bf16(xa, xb, XN + (size_t)m * 1024, XN + (size_t)mb * 1024, ssx + m, ssx + mb, lane); }
    }
#endif
    xcd_barrier(xbar);

#if PH_MASK & (1 << 1)
    {
        pg8::Gemm g{XN, Win_t, 1024, 1024, MTOK, NIN, 1024}; pg8::StaticOrder S; S.init(MTOK, NIN, G, bx); S.rev = true;
        pg8::EpiIn E{QAB, KAVA, KB, VB, GT, args.in[4], args.in[5], rope, ssx};
        pg8::gemm_phase<pg8::EpiIn, pg8::StaticOrder, true, true>(ldsp, g, S, E, wave);
    }
#endif
    xcd_barrier(xbar);

#if PH_MASK & (1 << 2)
    {
        using attn_body::bf16; const bf16* q = (const bf16*)QAB; bf16* o = (bf16*)QAB; const bf16* kava = (const bf16*)KAVA; const bf16* kb_ = (const bf16*)KB; const bf16* vb_ = (const bf16*)VB;
        char* shm = (char*)lds;
        const int nP = 1024, nS = 2048;
        const int perP = (nP + G - 1) / G, perS = (nS + G - 1) / G;
#ifndef NO_GQA
        bool nomax;
        { const int ln_ = lane_now(); float gq = __builtin_fabsf(args.in[4][ln_]), gk = __builtin_fabsf(args.in[5][ln_]);
#pragma unroll
          for (int o_ = 1; o_ < 64; o_ <<= 1) { gq = __builtin_fmaxf(gq, __shfl_xor(gq, o_)); gk = __builtin_fmaxf(gk, __shfl_xor(gk, o_)); }
          nomax = __builtin_amdgcn_readfirstlane((int)(11.78f * gq * gk <= 40.0f)) != 0; }
        { int slot = 0; bool pre = false; bf16* o = (bf16*)QAB;
        for (int li = 0; li < perP + perS; ++li) {
            const bool isP = li < perP; const int idx = isP ? vcu * perP + li : vcu * perS + (li - perP);
            if (idx >= (isP ? nP : nS)) continue;
            const int grp = isP ? idx >> 6 : idx >> 5, w = isP ? idx & 63 : idx & 31, b = grp >> 1, kvh = grp & 1, h = kvh * 4 + (isP ? w >> 4 : w >> 3), qb = isP ? w & 15 : w & 7;
            const size_t rb = isP ? (size_t)b * 4096 : (size_t)MP + (size_t)b * 2048; const int ntile = isP ? 64 : 32;
            const bf16* nK = nullptr; const bf16* nV = nullptr;
            { const int l2 = li + 1; if (l2 < perP + perS) { const bool p2 = l2 < perP; const int i2 = p2 ? vcu * perP + l2 : vcu * perS + (l2 - perP);
                if (i2 < (p2 ? nP : nS)) { const int g2 = p2 ? i2 >> 6 : i2 >> 5; const size_t rb2 = p2 ? (size_t)(g2 >> 1) * 4096 : (size_t)MP + (size_t)(g2 >> 1) * 2048; nK = kava + rb2 * 256 + (g2 & 1) * 64; nV = nK + 128; } } }
            if (nomax) slot = attn_body::attn_unit<-1, false>(q + (rb + qb * 256) * 1024 + h * 64, o + (rb + qb * 256) * 1024 + h * 64, 1024, kava + rb * 256 + kvh * 64, kava + rb * 256 + 128 + kvh * 64, 256, ntile, shm, nullptr, 0, 0, 0, wave, slot, pre, nK, nV);
            else       slot = attn_body::attn_unit<8, false>(q + (rb + qb * 256) * 1024 + h * 64, o + (rb + qb * 256) * 1024 + h * 64, 1024, kava + rb * 256 + kvh * 64, kava + rb * 256 + 128 + kvh * 64, 256, ntile, shm, nullptr, 0, 0, 0, wave, slot, pre, nK, nV);
            pre = nK != nullptr;
        } }
#endif
#ifndef NO_NA
        { int slot = 0; bool pre = false;
        for (int li = 0; li < perP + perS; ++li) {
            const attn_body::NaUnit u0 = attn_body::na_unit_of(li, vcu, perP, perS, nP, nS), u1 = attn_body::na_unit_of(li + 1, vcu, perP, perS, nP, nS);
            if (!u0.ok) continue;
            const bf16* nK = u1.ok ? kb_ + u1.koff : nullptr; const bf16* nV = u1.ok ? vb_ + u1.koff : nullptr;
            slot = attn_body::attn_unit<8, true>(q + u0.qoff, o + u0.qoff, 1024, kb_ + u0.koff, vb_ + u0.koff, 512, u0.nt, shm, args.in[6] + u0.h * 465, u0.lo, 4 * u0.qb, u0.rows, wave, slot, pre, nK, nV);
            pre = u1.ok;
        } }
#endif
    }
#endif
    xcd_barrier(xbar);

#if PH_MASK & (1 << 3)
    {
        pg8::Gemm g{QAB, Wp_t, 1024, 1024, MTOK, 1024, 1024}; pg8::StaticOrder S; S.init(MTOK, 1024, G, bx);
        pg8::EpiGate E{GT, MG};
        pg8::gemm_phase<pg8::EpiGate, pg8::StaticOrder, true, true>(ldsp, g, S, E, wave);
    }
#endif
    xcd_barrier(xbar);

#if PH_MASK & (1 << 4)
    {
        pg8::Gemm g{MG, Wo_t, 1024, 1024, MTOK, 1024, 1024}; pg8::StaticOrder S; S.init(MTOK, 1024, G, bx); S.rev = true;
        pg8::EpiH E{XN, HB, ss};
        pg8::gemm_phase<pg8::EpiH, pg8::StaticOrder, true, true>(ldsp, g, S, E, wave);
    }
#endif
    xcd_barrier(xbar);

#if PH_MASK & (1 << 5)
    {
        pg8::Gemm g{HB, Wup_t, 1024, 1024, MTOK, FF, 1024}; pg8::StaticOrder S; S.init(MTOK, FF, G, bx);
        pg8::EpiUp E{ss, U};
        pg8::gemm_phase<pg8::EpiUp, pg8::StaticOrder, true, true>(ldsp, g, S, E, wave);
#if PROBE_DUP == 5
        pg8::gemm_phase<pg8::EpiUp, pg8::StaticOrder, true, true>(ldsp, g, S, E, wave);
#endif
    }
#endif
    xcd_barrier(xbar);

#if PH_MASK & (1 << 6)
    {
        pg8::Gemm g{U, Wdn_t, FF, FF, MTOK, 1024, FF}; pg8::StaticOrder S; S.init(MTOK, 1024, G, bx); S.rev = true;
#if PROBE_DUP == 6
        { pg8::EpiH2 E0{HB, ss, (bf16*)out}; pg8::gemm_phase<pg8::EpiH2, pg8::StaticOrder, true, true>(ldsp, g, S, E0, wave); }
#endif
        pg8::EpiH2 E{HB, ss2, HB};
        pg8::gemm_phase<pg8::EpiH2, pg8::StaticOrder, true, true>(ldsp, g, S, E, wave);
    }
#endif
    xcd_barrier(xbar);

#if PH_MASK & (1 << 7)
    {
        int tid = (wave << 6) | lane_now(); asm volatile("" : "+v"(tid)); const int lane = tid & 63;
        const int gw = vcu * NWAVES + wave, NGW = G * NWAVES;
        for (int m = gw; m < MTOK; m += 4 * NGW) {
            v4u h[4][2]; float sq[4]; int mm[4];
#pragma unroll
            for (int r = 0; r < 4; ++r) { mm[r] = (m + r * NGW < MTOK) ? m + r * NGW : m; sq[r] = ss2[mm[r]];
#pragma unroll
                for (int j = 0; j < 2; ++j) h[r][j] = *((const GAS v4u*)(HB + (size_t)mm[r] * 1024) + lane + 64 * j); }
#pragma unroll
            for (int r = 0; r < 4; ++r) { const float rs = __builtin_amdgcn_rsqf(sq[r] * (1.f / 1024.f) + 1e-6f); float* orow = out + (size_t)mm[r] * 1024;
#pragma unroll
                for (int j = 0; j < 2; ++j) { const int c = (lane + 64 * j) * 8; const v4u hh = h[r][j];
                    const f32x4 g0 = *(const GAS f32x4*)(args.in[13] + c), g1 = *(const GAS f32x4*)(args.in[13] + c + 4);
                    f32x4 a, b; a[0] = pg8::bflo(hh.x); a[1] = pg8::bfhi(hh.x); a[2] = pg8::bflo(hh.y); a[3] = pg8::bfhi(hh.y); b[0] = pg8::bflo(hh.z); b[1] = pg8::bfhi(hh.z); b[2] = pg8::bflo(hh.w); b[3] = pg8::bfhi(hh.w);
                    *(GAS f32x4*)(orow + c) = a * rs * g0; *(GAS f32x4*)(orow + c + 4) = b * rs * g1; } } }
    }
#endif
}

extern "C" void kernel_launch(void* const* d_in, const int* in_sizes, int n_in, void* d_out, int out_size, void* d_ws, size_t ws_size, hipStream_t stream) {
    static int grid = 0;
    if (grid == 0) {
        if (n_in != 14 || in_sizes[0] != MP * 1024 || in_sizes[1] != MS * 1024 || out_size != MTOK * 1024 || ws_size < WS_END) {
            fprintf(stderr, "kernel_launch: unexpected shapes / workspace (n_in %d, ws %zu); nothing launched\n", n_in, ws_size); grid = -1; return; }
        int dev = 0, cus = 0, per_cu = 0;
        (void)hipGetDevice(&dev); (void)hipDeviceGetAttribute(&cus, hipDeviceAttributeMultiprocessorCount, dev);
        (void)hipFuncSetAttribute((const void*)fwd_kernel, hipFuncAttributeMaxDynamicSharedMemorySize, LDS_BYTES);
        (void)hipOccupancyMaxActiveBlocksPerMultiprocessor(&per_cu, (const void*)fwd_kernel, NWAVES * 64, LDS_BYTES);
        (void)hipGetLastError();
        if (per_cu < 1) per_cu = 1;
        grid = cus * 1;
        if (grid <= 0) { grid = -1; return; }
    }
    if (grid < 0) return;
    (void)hipMemsetAsync((unsigned char*)d_ws + WS_BAR, 0, XCD_BAR_WORDS * 4, stream);
    Args a{};
    for (int i = 0; i < 14; ++i) a.in[i] = (const float*)d_in[i];
    a.out = (float*)d_out; a.ws = (unsigned char*)d_ws;
    void* kargs[] = {&a};
    hipError_t e = hipLaunchCooperativeKernel((const void*)fwd_kernel, dim3(grid), dim3(NWAVES * 64), kargs, LDS_BYTES, stream);
    if (e != hipSuccess) fprintf(stderr, "cooperative launch failed: %s (grid %d)\n", hipGetErrorString(e), grid);
}
```

```cpp
#include <hip/hip_runtime.h>
#include <hip/hip_cooperative_groups.h>
#include <hip/hip_bf16.h>
#include <cstdio>
#include <cstdint>
#include <cmath>
namespace cg = cooperative_groups;

__device__ __forceinline__ int lane_now() { int l; asm volatile("v_mbcnt_lo_u32_b32 %0, -1, 0\n\tv_mbcnt_hi_u32_b32 %0, -1, %0" : "=v"(l)); return l; }
namespace pg8 {
#define PG8_LAS __attribute__((address_space(3)))
typedef unsigned short bf16_t;
typedef short bf16x8 __attribute__((ext_vector_type(8)));
typedef float f32x4 __attribute__((ext_vector_type(4)));
typedef unsigned u32x4 __attribute__((ext_vector_type(4)));
constexpr int BM = 256, BK = 64, HALF = 128, HTB = HALF * BK * 2, STAGE_BYTES = 8 * HTB, NXCD = 8, WGM = 8;
constexpr float C2Q = 0.125f * 1.4426950408889634f;
constexpr float LOG2E = 1.4426950408889634f;

__host__ __device__ __forceinline__ int lds_byte(int r, int c) { const int st = (r >> 4) * 2 + (c >> 5), rr = r & 15, cc = c & 31, ob = rr * 64 + cc * 2; return st * 1024 + (ob ^ (((ob >> 9) & 1) << 5)); }
__host__ __device__ __forceinline__ void stage_rc(int b, int& R, int& C) { const int st = b / 1024, sb = b % 1024, swz = sb ^ (((sb >> 9) & 1) << 5); R = (st >> 1) * 16 + swz / 64; C = (st & 1) * 32 + (swz % 64) / 2; }
__host__ __device__ __forceinline__ int perm32(int rho) { const int n = rho >> 4, i = rho & 15; return 8 * (i >> 2) + 4 * n + (i & 3); }

struct Unit { int pm, pn; };
struct Gemm { const bf16_t* A; const bf16_t* Bt; int lda, ldb; int M, N, K; };

struct StaticOrder {
    int nM, nN, nwg, G, c; bool rev;
    __host__ __device__ void init(int M, int N, int G_, int c_) { nM = M / BM; nN = N / BM; nwg = nM * nN; G = G_; c = c_; rev = false; }
    __host__ __device__ bool next(int i, Unit& u) const {
        const long L = (long)i * G + c; if (L >= nwg) return false;
        int wgid = (int)L; { const int q = nwg / NXCD, r = nwg % NXCD, xcd = wgid % NXCD, off = wgid / NXCD; wgid = (xcd < r ? xcd * (q + 1) : r * (q + 1) + (xcd - r) * q) + off; }
        const int nig = WGM * nN, gid = wgid / nig, fm = gid * WGM, gsz = (nM - fm) < WGM ? (nM - fm) : WGM;
        u.pm = fm + ((wgid % nig) % gsz); u.pn = (wgid % nig) / gsz; if (rev) u.pm = nM - 1 - u.pm; return true;
    }
    __device__ __forceinline__ void a_ready(const Unit&) const {}
    __device__ __forceinline__ void done(const Unit&) const {}
};

typedef float f32x2 __attribute__((ext_vector_type(2)));
typedef __bf16 bf16x2v __attribute__((ext_vector_type(2)));
__device__ __forceinline__ unsigned pkbf(float lo, float hi) { f32x2 v = {lo, hi}; bf16x2v b = __builtin_convertvector(v, bf16x2v); return __builtin_bit_cast(unsigned, b); }
__device__ __forceinline__ float bflo(unsigned w) { return __uint_as_float(w << 16); }
__device__ __forceinline__ float bfhi(unsigned w) { return __uint_as_float(w & 0xffff0000u); }
__device__ __forceinline__ u32x4 pk8(const f32x4 a, const f32x4 b) { u32x4 w; w.x = pkbf(a[0], a[1]); w.y = pkbf(a[2], a[3]); w.z = pkbf(b[0], b[1]); w.w = pkbf(b[2], b[3]); return w; }
__device__ __forceinline__ float sigm(float v) { return __builtin_amdgcn_rcpf(1.0f + __builtin_amdgcn_exp2f(-LOG2E * v)); }
__device__ __forceinline__ float sumsq4(const f32x4 a) { return (a[0] * a[0] + a[1] * a[1]) + (a[2] * a[2] + a[3] * a[3]); }

struct EpiIn {
    static constexpr bool PERM = true, AFTER_DRAIN = false, HAS_PRE = true; static constexpr int MIDK = 0;
    bf16_t *QAB, *KAVA, *KB, *VB, *G; const float* qg; const float* kg; const float* rope; const float* ssx;
    __device__ __forceinline__ void pre(const Unit& u, int wr, int fr, float (&pf)[8]) const {
        const int row0 = u.pm * BM + wr * 64 + fr;
#pragma unroll
        for (int ai = 0; ai < 2; ++ai)
#pragma unroll
            for (int m = 0; m < 4; ++m) pf[ai * 4 + m] = ssx[(size_t)(row0 + ai * HALF + m * 16)];
    }
    __device__ __forceinline__ void operator()(const f32x4 (&acc)[2][2][4][2], const Unit& u, int wr, int wc, int fr, int fq, const float (&pf)[8]) const {
        const int pn = u.pn; const int row0 = u.pm * BM + wr * 64 + fr;
        if (pn < 3) {
            const bool isq = pn < 2, nrm = isq || wc < 2;
            bf16_t* dst = isq ? QAB : KAVA; const int pitch = isq ? 1024 : 256; const int colb = (isq ? 256 * pn : 0) + 64 * wc + 8 * fq;
            const float osc = isq ? C2Q : 1.f; const float* gp = isq ? qg : kg;
            f32x4 gv[2][2];
#pragma unroll
            for (int bj = 0; bj < 2; ++bj)
#pragma unroll
                for (int n = 0; n < 2; ++n) gv[bj][n] = *(const f32x4*)(gp + 32 * bj + 8 * fq + 4 * n);
            const bool prompt = u.pm < 128; const int smask = prompt ? 4095 : 2047, toff = prompt ? 0 : 32768;
#pragma unroll
            for (int ai = 0; ai < 2; ++ai) {
                const int grow = (((u.pm * BM + ai * HALF + wr * 64) - toff) & smask) >> 6;
                const f32x4 cr0 = *(const f32x4*)(rope + (grow * 16 + 4 * fq) * 2), cr1 = *(const f32x4*)(rope + (grow * 16 + 4 * fq + 2) * 2);
#pragma unroll
                for (int m = 0; m < 4; ++m) {
                    const int row = row0 + ai * HALF + m * 16; const int gcol = m * 16 + fr; const float rsx = __builtin_amdgcn_rsqf(pf[ai * 4 + m] * (1.0f / 1024.0f) + 1e-6f);
                    f32x4 v[2][2];
#pragma unroll
                    for (int bj = 0; bj < 2; ++bj)
#pragma unroll
                        for (int n = 0; n < 2; ++n) v[bj][n] = acc[ai][bj][m][n] * rsx;
                    if (nrm) {
                        float ss = (sumsq4(v[0][0]) + sumsq4(v[0][1])) + (sumsq4(v[1][0]) + sumsq4(v[1][1]));
                        ss += __shfl_xor(ss, 16); ss += __shfl_xor(ss, 32);
                        const float rinv = __builtin_amdgcn_rsqf(ss * (1.0f / 64.0f) + 1e-6f);
                        const f32x4 cc0 = *(const f32x4*)(rope + (gcol * 16 + 4 * fq) * 2), cc1 = *(const f32x4*)(rope + (gcol * 16 + 4 * fq + 2) * 2);
#pragma unroll
                        for (int bj = 0; bj < 2; ++bj)
#pragma unroll
                            for (int n = 0; n < 2; ++n) {
                                const f32x4 x = v[bj][n] * rinv * gv[bj][n]; const f32x4 cs = bj == 0 ? (n == 0 ? cr0 : cr1) : (n == 0 ? cc0 : cc1);
                                f32x4 o; o[0] = x[0] * cs[0] - x[1] * cs[1]; o[1] = x[0] * cs[1] + x[1] * cs[0]; o[2] = x[2] * cs[2] - x[3] * cs[3]; o[3] = x[2] * cs[3] + x[3] * cs[2];
                                v[bj][n] = o * osc; }
                    }
                    bf16_t* rowp = dst + (size_t)row * pitch + colb;
                    *(u32x4*)(rowp) = pk8(v[0][0], v[0][1]); *(u32x4*)(rowp + 32) = pk8(v[1][0], v[1][1]);
                }
            }
        } else {
            const int t = pn - 3; bf16_t* dst; int pitch, colt; float sc = 1.f; bool sg = false;
            if (t < 2) { dst = QAB; pitch = 1024; colt = 512 + 256 * t; sc = C2Q; } else if (t < 4) { dst = KB; pitch = 512; colt = 256 * (t - 2); }
            else if (t < 6) { dst = VB; pitch = 512; colt = 256 * (t - 4); } else { dst = G; pitch = 2048; colt = 128 * (t - 6); sg = true; }
            const int col0 = colt + wc * 32 + 8 * fq;
            if (sg) {
#pragma unroll
                for (int ai = 0; ai < 2; ++ai)
#pragma unroll
                    for (int m = 0; m < 4; ++m) { bf16_t* rowp = dst + (size_t)(row0 + ai * HALF + m * 16) * pitch + col0; const float rsl = -LOG2E * __builtin_amdgcn_rsqf(pf[ai * 4 + m] * (1.0f / 1024.0f) + 1e-6f);
                        f32x4 r0, r1, s0, s1;
#pragma unroll
                        for (int i = 0; i < 4; ++i) { const float ea0 = __builtin_amdgcn_exp2f(rsl * acc[ai][0][m][0][i]), ea1 = __builtin_amdgcn_exp2f(rsl * acc[ai][0][m][1][i]);
                            const float eb0 = __builtin_amdgcn_exp2f(rsl * acc[ai][1][m][0][i]), eb1 = __builtin_amdgcn_exp2f(rsl * acc[ai][1][m][1][i]);
                            s0[i] = __builtin_amdgcn_rcpf(1.0f + eb0); s1[i] = __builtin_amdgcn_rcpf(1.0f + eb1);
                            r0[i] = (1.0f + eb0) * __builtin_amdgcn_rcpf(1.0f + ea0); r1[i] = (1.0f + eb1) * __builtin_amdgcn_rcpf(1.0f + ea1); }
                        *(u32x4*)(rowp) = pk8(r0, r1); *(u32x4*)(rowp + 1024) = pk8(s0, s1); }
                return;
            }
#pragma unroll
            for (int ai = 0; ai < 2; ++ai)
#pragma unroll
                for (int m = 0; m < 4; ++m) { bf16_t* rowp = dst + (size_t)(row0 + ai * HALF + m * 16) * pitch + col0; const float rsx = __builtin_amdgcn_rsqf(pf[ai * 4 + m] * (1.0f / 1024.0f) + 1e-6f);
#pragma unroll
                    for (int bj = 0; bj < 2; ++bj) { f32x4 v0 = acc[ai][bj][m][0] * rsx, v1 = acc[ai][bj][m][1] * rsx;
                        if (sg) {
#pragma unroll
                            for (int i = 0; i < 4; ++i) { v0[i] = sigm(v0[i]); v1[i] = sigm(v1[i]); } }
                        else { v0 = v0 * sc; v1 = v1 * sc; }
                        *(u32x4*)(rowp + bj * HALF) = pk8(v0, v1); } }
        }
    }
};
struct EpiGate {
    static constexpr bool PERM = true, AFTER_DRAIN = false, HAS_PRE = false; static constexpr int MIDK = 8;
    const bf16_t* G; bf16_t* MG;
    __device__ __forceinline__ void scale(f32x4 (&acc)[2][2][4][2], const Unit& u, int wr, int wc, int fr, int fq, int goff) const {
        asm volatile("" : "+v"(fr), "+v"(fq));
        const int row0 = u.pm * BM + wr * 64 + fr, col0 = u.pn * BM + wc * 32 + 8 * fq;
#pragma unroll
        for (int ai = 0; ai < 2; ++ai)
#pragma unroll
            for (int m = 0; m < 4; ++m) { const size_t row = (size_t)(row0 + ai * HALF + m * 16);
#pragma unroll
                for (int bj = 0; bj < 2; ++bj) { const u32x4 g = *(const u32x4*)(G + row * 2048 + goff + col0 + bj * HALF);
                    f32x4& v0 = acc[ai][bj][m][0]; f32x4& v1 = acc[ai][bj][m][1];
                    v0[0] *= bflo(g.x); v0[1] *= bfhi(g.x); v0[2] *= bflo(g.y); v0[3] *= bfhi(g.y); v1[0] *= bflo(g.z); v1[1] *= bfhi(g.z); v1[2] *= bflo(g.w); v1[3] *= bfhi(g.w); }
                if (m & 1) asm volatile("" ::: "memory"); }
    }
    __device__ __forceinline__ void mid(f32x4 (&acc)[2][2][4][2], const Unit& u, int wr, int wc, int fr, int fq) const { scale(acc, u, wr, wc, fr, fq, 0); }
    __device__ __forceinline__ void operator()(const f32x4 (&acc)[2][2][4][2], const Unit& u, int wr, int wc, int fr, int fq) const {
        asm volatile("" : "+v"(fr), "+v"(fq));
        const int row0 = u.pm * BM + wr * 64 + fr, col0 = u.pn * BM + wc * 32 + 8 * fq;
#pragma unroll
        for (int ai = 0; ai < 2; ++ai)
#pragma unroll
            for (int m = 0; m < 4; ++m) { const size_t row = (size_t)(row0 + ai * HALF + m * 16);
#pragma unroll
                for (int bj = 0; bj < 2; ++bj) { const u32x4 g = *(const u32x4*)(G + row * 2048 + 1024 + col0 + bj * HALF);
                    f32x4 v0 = acc[ai][bj][m][0], v1 = acc[ai][bj][m][1];
                    v0[0] *= bflo(g.x); v0[1] *= bfhi(g.x); v0[2] *= bflo(g.y); v0[3] *= bfhi(g.y); v1[0] *= bflo(g.z); v1[1] *= bfhi(g.z); v1[2] *= bflo(g.w); v1[3] *= bfhi(g.w);
                    *(u32x4*)(MG + row * 1024 + col0 + bj * HALF) = pk8(v0, v1); } }
    }
};
struct EpiH {
    static constexpr bool PERM = true, AFTER_DRAIN = false, HAS_PRE = false; static constexpr int MIDK = 0;
    const bf16_t* XB; bf16_t* HB; float* ss;
    __device__ __forceinline__ void operator()(const f32x4 (&acc)[2][2][4][2], const Unit& u, int wr, int wc, int fr, int fq) const {
        const int row0 = u.pm * BM + wr * 64 + fr, col0 = u.pn * BM + wc * 32 + 8 * fq;
#pragma unroll
        for (int ai = 0; ai < 2; ++ai)
#pragma unroll
            for (int m = 0; m < 4; ++m) { const size_t row = (size_t)(row0 + ai * HALF + m * 16); float s = 0.f;
#pragma unroll
                for (int bj = 0; bj < 2; ++bj) { const size_t off = row * 1024 + col0 + bj * HALF; const u32x4 h = *(const u32x4*)(XB + off);
                    f32x4 a = acc[ai][bj][m][0], b = acc[ai][bj][m][1];
                    a[0] += bflo(h.x); a[1] += bfhi(h.x); a[2] += bflo(h.y); a[3] += bfhi(h.y); b[0] += bflo(h.z); b[1] += bfhi(h.z); b[2] += bflo(h.w); b[3] += bfhi(h.w);
                    s += sumsq4(a) + sumsq4(b); *(u32x4*)(HB + off) = pk8(a, b); }
                s += __shfl_xor(s, 16); s += __shfl_xor(s, 32);
                if (fq == 0) unsafeAtomicAdd(ss + row, s); }
    }
};
struct EpiH2 {
    static constexpr bool PERM = true, AFTER_DRAIN = false, HAS_PRE = false; static constexpr int MIDK = 0;
    bf16_t* HB; float* ss; bf16_t* HO;
    __device__ __forceinline__ void operator()(const f32x4 (&acc)[2][2][4][2], const Unit& u, int wr, int wc, int fr, int fq) const {
        const int row0 = u.pm * BM + wr * 64 + fr, col0 = u.pn * BM + wc * 32 + 8 * fq;
#pragma unroll
        for (int ai = 0; ai < 2; ++ai)
#pragma unroll
            for (int m = 0; m < 4; ++m) { const size_t row = (size_t)(row0 + ai * HALF + m * 16); float s = 0.f;
#pragma unroll
                for (int bj = 0; bj < 2; ++bj) { const size_t off = row * 1024 + col0 + bj * HALF; const u32x4 h = *(const u32x4*)(HB + off);
                    f32x4 a = acc[ai][bj][m][0], b = acc[ai][bj][m][1];
                    a[0] += bflo(h.x); a[1] += bfhi(h.x); a[2] += bflo(h.y); a[3] += bfhi(h.y); b[0] += bflo(h.z); b[1] += bfhi(h.z); b[2] += bflo(h.w); b[3] += bfhi(h.w);
                    s += sumsq4(a) + sumsq4(b); *(u32x4*)(HO + off) = pk8(a, b); }
                s += __shfl_xor(s, 16); s += __shfl_xor(s, 32);
                if (fq == 0) unsafeAtomicAdd(ss + row, s); }
    }
};
struct EpiUp {
    static constexpr bool PERM = true, AFTER_DRAIN = false, HAS_PRE = true; static constexpr int MIDK = 0;
    const float* ss; bf16_t* U;
    __device__ __forceinline__ void pre(const Unit& u, int wr, int fr, float (&pf)[8]) const {
        const int row0 = u.pm * BM + wr * 64 + fr;
#pragma unroll
        for (int ai = 0; ai < 2; ++ai)
#pragma unroll
            for (int m = 0; m < 4; ++m) pf[ai * 4 + m] = ss[(size_t)(row0 + ai * HALF + m * 16)];
    }
    __device__ __forceinline__ void operator()(const f32x4 (&acc)[2][2][4][2], const Unit& u, int wr, int wc, int fr, int fq, const float (&pf)[8]) const {
        const int row0 = u.pm * BM + wr * 64 + fr, col0 = u.pn * BM + wc * 32 + 8 * fq;
#pragma unroll
        for (int ai = 0; ai < 2; ++ai)
#pragma unroll
            for (int m = 0; m < 4; ++m) { const size_t row = (size_t)(row0 + ai * HALF + m * 16); const float rs = __builtin_amdgcn_rsqf(pf[ai * 4 + m] * (1.0f / 1024.0f) + 1e-6f);
#pragma unroll
                for (int bj = 0; bj < 2; ++bj) { f32x4 v0 = acc[ai][bj][m][0] * rs, v1 = acc[ai][bj][m][1] * rs;
#pragma unroll
                    for (int i = 0; i < 4; ++i) { const float a = __builtin_fmaxf(v0[i], 0.f), b = __builtin_fmaxf(v1[i], 0.f); v0[i] = a * a; v1[i] = b * b; }
                    *(u32x4*)(U + row * 4096 + col0 + bj * HALF) = pk8(v0, v1); } }
    }
};

template <class Epi, class Sched, bool ALIGN_EPI = false, bool SP2 = false>
__device__ __forceinline__ void gemm_phase(PG8_LAS unsigned char* lds, const Gemm g, const Sched& S, const Epi& E, const int wave_s) {
    int tid_ = (wave_s << 6) | lane_now(); asm volatile("" : "+v"(tid_));
    const int tid = tid_, wid = __builtin_amdgcn_readfirstlane(tid >> 6), lane = tid & 63, wr = wid >> 2, wc = wid & 3, fr = lane & 15, fq = lane >> 4;
    const int K = g.K, nt = K / BK, lda = g.lda, ldb = g.ldb;
    unsigned voffA[2], voffB[2];
#pragma unroll
    for (int i = 0; i < 2; ++i) { int R, C; stage_rc(tid * 16 + i * 8192, R, C); const int Rb = Epi::PERM ? ((R & ~31) + perm32(R & 31)) : R;
        voffA[i] = (unsigned)(R * lda + C) * 2u; voffB[i] = (unsigned)(Rb * ldb + C) * 2u; }
    const size_t kstep = (size_t)(BK * 2);
    const size_t hA = (size_t)HALF * lda * 2, hB = (size_t)HALF * ldb * 2;
    const size_t tA = 2 * hA, tB = 2 * hB;
    const unsigned ldsw = (unsigned)wid * 1024u;
    const int aoff = lds_byte(wr * 64 + fr, fq * 8), boff = lds_byte(wc * 32 + fr, fq * 8);
#define PG8_SA(b, h) (((b) * 2 + (h)) * HTB)
#define PG8_SB(b, h) ((4 + (b) * 2 + (h)) * HTB)
#define PG8_STAGE(bufoff, gbase, voff) do { _Pragma("unroll") for (int _i = 0; _i < 2; ++_i) \
        __builtin_amdgcn_global_load_lds((const unsigned*)((const char*)(gbase) + (voff)[_i]), (PG8_LAS unsigned*)(lds + (bufoff) + ldsw + _i * 8192), 16, 0, 0); } while (0)
#define PG8_LDA(dst, b, h) do { _Pragma("unroll") for (int m = 0; m < 4; ++m) _Pragma("unroll") for (int k = 0; k < 2; ++k) dst[m][k] = *(const PG8_LAS bf16x8*)(lds + PG8_SA(b, h) + aoff + m * 2048 + k * 1024); } while (0)
#define PG8_LDB(dst, b, h) do { _Pragma("unroll") for (int n = 0; n < 2; ++n) _Pragma("unroll") for (int k = 0; k < 2; ++k) dst[n][k] = *(const PG8_LAS bf16x8*)(lds + PG8_SB(b, h) + boff + n * 2048 + k * 1024); } while (0)
#define PG8_MMA(ai, bj, At, Bt) do { __builtin_amdgcn_s_setprio(1); _Pragma("unroll") for (int m = 0; m < 4; ++m) _Pragma("unroll") for (int n = 0; n < 2; ++n) _Pragma("unroll") for (int k = 0; k < 2; ++k) \
        acc[ai][bj][m][n] = __builtin_amdgcn_mfma_f32_16x16x32_bf16(Bt[n][k], At[m][k], acc[ai][bj][m][n], 0, 0, 0); __builtin_amdgcn_s_setprio(0); } while (0)
#define PG8_WAIT_V(n) asm volatile("s_waitcnt vmcnt(" #n ")" ::: "memory")
#define PG8_WAIT_L(n) asm volatile("s_waitcnt lgkmcnt(" #n ")" ::: "memory")
#define PG8_BAR __builtin_amdgcn_s_barrier()
#define PG8_SCHED __builtin_amdgcn_sched_barrier(0)
    Unit cur, nxt; int ui = 0; float pf[8] = {0.f, 0.f, 0.f, 0.f, 0.f, 0.f, 0.f, 0.f};
    if (!S.next(0, cur)) return;
    f32x4 acc[2][2][4][2];
#pragma unroll
    for (int a = 0; a < 2; ++a)
#pragma unroll
        for (int b = 0; b < 2; ++b)
#pragma unroll
            for (int m = 0; m < 4; ++m)
#pragma unroll
                for (int n = 0; n < 2; ++n) acc[a][b][m][n] = (f32x4){0.f, 0.f, 0.f, 0.f};
    bf16x8 At[4][2], B0[2][2], B1[2][2];
    const char* cA = (const char*)g.A + (size_t)cur.pm * tA; const char* cB = (const char*)g.Bt + (size_t)cur.pn * tB;
    S.a_ready(cur);
    if constexpr (SP2) {
        PG8_STAGE(PG8_SB(0, 0), cB, voffB); PG8_STAGE(PG8_SB(0, 1), cB + hB, voffB); PG8_STAGE(PG8_SA(0, 0), cA, voffA); PG8_STAGE(PG8_SA(0, 1), cA + hA, voffA);
        if (wr == 1) PG8_BAR;
        PG8_WAIT_V(2); PG8_BAR;
        PG8_STAGE(PG8_SB(1, 0), cB + kstep, voffB); PG8_STAGE(PG8_SA(1, 0), cA + kstep, voffA); PG8_STAGE(PG8_SB(1, 1), cB + hB + kstep, voffB);
        PG8_WAIT_V(6); PG8_BAR;
    } else {
        PG8_STAGE(PG8_SB(0, 0), cB, voffB); PG8_STAGE(PG8_SA(0, 0), cA, voffA); PG8_STAGE(PG8_SB(0, 1), cB + hB, voffB); PG8_STAGE(PG8_SA(0, 1), cA + hA, voffA);
        if (wr == 1) PG8_BAR;
        PG8_WAIT_V(4); PG8_BAR;
        PG8_STAGE(PG8_SB(1, 0), cB + kstep, voffB); PG8_STAGE(PG8_SA(1, 0), cA + kstep, voffA); PG8_STAGE(PG8_SB(1, 1), cB + hB + kstep, voffB);
        PG8_WAIT_V(6); PG8_BAR;
    }
    for (;;) {
        const bool has_next = S.next(ui + 1, nxt);
        const char* nA = has_next ? (const char*)g.A + (size_t)nxt.pm * tA : cA; const char* nB = has_next ? (const char*)g.Bt + (size_t)nxt.pn * tB : cB;
        for (int t = 0; t < nt; t += 2) {
            if constexpr (Epi::MIDK > 0) { if (t == Epi::MIDK) E.mid(acc, cur, wr, wc, fr, fq); }
            const bool last = (t == nt - 2);
            if constexpr (Epi::HAS_PRE) { if (last) E.pre(cur, wr, fr, pf); }
            const char* a1 = cA + (size_t)(t + 1) * kstep;
            const char* a2 = last ? nA : cA + (size_t)(t + 2) * kstep; const char* b2 = last ? nB : cB + (size_t)(t + 2) * kstep;
            const char* a3 = a2 + kstep; const char* b3 = b2 + kstep;
            if (last && has_next) S.a_ready(nxt);
            if constexpr (SP2) {
            PG8_LDB(B0, 0, 0); PG8_LDB(B1, 0, 1); PG8_SCHED; PG8_LDA(At, 0, 0); PG8_STAGE(PG8_SA(1, 1), a1 + hA, voffA);
            PG8_WAIT_V(8); PG8_WAIT_L(0); PG8_BAR; PG8_MMA(0, 0, At, B0); PG8_MMA(0, 1, At, B1); PG8_BAR; PG8_SCHED;
            PG8_LDA(At, 0, 1); PG8_STAGE(PG8_SB(0, 0), b2, voffB); PG8_STAGE(PG8_SB(0, 1), b2 + hB, voffB); PG8_STAGE(PG8_SA(0, 0), a2, voffA);
            PG8_WAIT_V(8); PG8_WAIT_L(0); PG8_BAR; PG8_MMA(1, 0, At, B0); PG8_MMA(1, 1, At, B1); PG8_BAR; PG8_SCHED;
            PG8_LDB(B0, 1, 0); PG8_LDB(B1, 1, 1); PG8_SCHED; PG8_LDA(At, 1, 0); PG8_STAGE(PG8_SA(0, 1), a2 + hA, voffA);
            PG8_WAIT_V(8); PG8_WAIT_L(0); PG8_BAR; PG8_MMA(0, 0, At, B0); PG8_MMA(0, 1, At, B1); PG8_BAR; PG8_SCHED;
            PG8_LDA(At, 1, 1); PG8_STAGE(PG8_SB(1, 0), b3, voffB); PG8_STAGE(PG8_SB(1, 1), b3 + hB, voffB); PG8_STAGE(PG8_SA(1, 0), a3, voffA);
            PG8_WAIT_V(8); PG8_WAIT_L(0); PG8_BAR; PG8_MMA(1, 0, At, B0); PG8_MMA(1, 1, At, B1); PG8_BAR; PG8_SCHED;
            } else {
            PG8_LDB(B0, 0, 0); PG8_SCHED; PG8_LDA(At, 0, 0); PG8_STAGE(PG8_SA(1, 1), a1 + hA, voffA);
            PG8_WAIT_L(8); PG8_BAR; PG8_WAIT_L(0); PG8_MMA(0, 0, At, B0); PG8_BAR; PG8_SCHED;
            PG8_LDB(B1, 0, 1); PG8_STAGE(PG8_SB(0, 0), b2, voffB);
            PG8_BAR; PG8_WAIT_L(0); PG8_MMA(0, 1, At, B1); PG8_BAR;
            PG8_LDA(At, 0, 1); PG8_STAGE(PG8_SA(0, 0), a2, voffA);
            PG8_BAR; PG8_WAIT_L(0); PG8_MMA(1, 0, At, B0); PG8_BAR; PG8_SCHED;
            PG8_STAGE(PG8_SB(0, 1), b2 + hB, voffB);
            PG8_WAIT_V(6); PG8_BAR; PG8_MMA(1, 1, At, B1); PG8_BAR;
            PG8_LDB(B0, 1, 0); PG8_SCHED; PG8_LDA(At, 1, 0); PG8_STAGE(PG8_SA(0, 1), a2 + hA, voffA);
            PG8_WAIT_L(8); PG8_BAR; PG8_WAIT_L(0); PG8_MMA(0, 0, At, B0); PG8_BAR; PG8_SCHED;
            PG8_LDB(B1, 1, 1); PG8_STAGE(PG8_SB(1, 0), b3, voffB);
            PG8_BAR; PG8_WAIT_L(0); PG8_MMA(0, 1, At, B1); PG8_BAR;
            PG8_LDA(At, 1, 1); PG8_STAGE(PG8_SA(1, 0), a3, voffA);
            PG8_BAR; PG8_WAIT_L(0); PG8_MMA(1, 0, At, B0); PG8_BAR; PG8_SCHED;
            PG8_STAGE(PG8_SB(1, 1), b3 + hB, voffB);
            PG8_WAIT_V(6); PG8_BAR; PG8_MMA(1, 1, At, B1); PG8_BAR;
            }
        }
        if constexpr (ALIGN_EPI) { if (wr == 0) PG8_BAR; }
        if constexpr (!Epi::AFTER_DRAIN) { if constexpr (Epi::HAS_PRE) E(acc, cur, wr, wc, fr, fq, pf); else E(acc, cur, wr, wc, fr, fq); S.done(cur); }
        if (!has_next) break;
#pragma unroll
        for (int a = 0; a < 2; ++a)
#pragma unroll
            for (int b = 0; b < 2; ++b)
#pragma unroll
                for (int m = 0; m < 4; ++m)
#pragma unroll
                    for (int n = 0; n < 2; ++n) acc[a][b][m][n] = (f32x4){0.f, 0.f, 0.f, 0.f};
        cur = nxt; cA = nA; cB = nB; ++ui;
        if constexpr (ALIGN_EPI) { if (wr == 1) PG8_BAR; }
    }
    PG8_WAIT_V(0);
    if constexpr (!ALIGN_EPI) { if (wr == 0) PG8_BAR; }
    PG8_BAR;
    if constexpr (Epi::AFTER_DRAIN) { E.fused(acc, cur, wr, wc, fr, fq, lds, wid, lane); S.done(cur); }
#undef PG8_SA
#undef PG8_SB
#undef PG8_STAGE
#undef PG8_LDA
#undef PG8_LDB
#undef PG8_MMA
#undef PG8_WAIT_V
#undef PG8_WAIT_L
#undef PG8_BAR
#undef PG8_SCHED
}
}

namespace attn_body {
using bf16=__hip_bfloat16;
using bf16x8=__attribute__((ext_vector_type(8)))short;
using s16x4=__attribute__((ext_vector_type(4)))short;
using f32x16=__attribute__((ext_vector_type(16)))float;
using u32x4=__attribute__((ext_vector_type(4)))unsigned;
constexpr int D=64;
constexpr int NW=8,QBLK=32,QB=QBLK*NW,KVBLK=64;
constexpr int NA_TBL_OFF=88064;
typedef const __attribute__((address_space(3))) float* na_lptr;
__device__ __forceinline__ int crow(int r,int hi){return (r&3)+8*(r>>2)+4*hi;}
#define SBAR() __builtin_amdgcn_sched_barrier(0)
#define ATTN_STORE16(p,v) (*(u32x4*)(p)=(v))
#define NA_SETUP \
  int na_qr=0,na_off=0,na_rsw=0; unsigned na_mw=0u; na_lptr na_tbl=(na_lptr)((const __attribute__((address_space(3))) char*)shm+NA_TBL_OFF); \
  if constexpr(NA){ na_qr=qrow0+(wid>>1); const int na_qc=32*(wid&1)+r32; na_off=15-na_qc+4*hi; { int a_=na_qr-4; a_=a_<0?0:a_; const int m_=nrows-8; na_rsw=a_>m_?m_:a_; } \
    { int c_=na_qc-8; c_=c_<0?0:c_; c_=c_>48?48:c_; _Pragma("unroll") for(int r=0;r<16;++r){ const int kc_=(r&3)+8*(r>>2)+4*hi; na_mw|=(((unsigned)(kc_-c_)<16u)?1u:0u)<<r; na_mw|=(((unsigned)(kc_+32-c_)<16u)?1u:0u)<<(16+r); } } \
    if(tid<465)((__attribute__((address_space(3))) float*)((__attribute__((address_space(3))) char*)shm+NA_TBL_OFF))[tid]=rpbh[tid]*1.4426950408889634f; }
#define NA_LD(D,W,R4) do{ _Pragma("unroll") for(int i_=0;i_<4;++i_) D[i_]=tp_[(((R4)+i_)&3)+8*(((R4)+i_)>>2)+32*(W)]; }while(0)
#define NA_CP(S_,P,W,R4) do{ _Pragma("unroll") for(int i_=0;i_<4;++i_){ unsigned m_; asm("v_bfe_i32 %0, %1, %2, 1":"=v"(m_):"v"(mw_),"n"(16*(W)+(R4)+i_)); const float x_=P[(R4)+i_]+(S_[i_]-mhat); P[(R4)+i_]=__uint_as_float((__float_as_uint(x_)&m_)|(0xFF800000u&~m_)); } }while(0)
#define NAMASK(P0,P1,t) do{ if constexpr(NA){ const int kr_=b0+(t); f32x16&P0_=P0; f32x16&P1_=P1; \
   if(kr_>=na_rsw && kr_<na_rsw+8){ const na_lptr tp_=na_tbl+((kr_-na_qr+7)*31+na_off); unsigned mw_=na_mw; asm volatile("":"+v"(mw_)); float ga_[4],gb_[4]; \
     if((wid&1)==0){ \
       NA_LD(ga_,0,0); NA_LD(gb_,0,4); SBAR(); NA_CP(ga_,P0_,0,0); NA_LD(ga_,0,8); SBAR(); NA_CP(gb_,P0_,0,4); NA_LD(gb_,0,12); SBAR(); \
       NA_CP(ga_,P0_,0,8); NA_LD(ga_,1,0); SBAR(); NA_CP(gb_,P0_,0,12); SBAR(); NA_CP(ga_,P1_,1,0); \
       _Pragma("unroll") for(int r=4;r<16;++r)P1_[r]=-INFINITY; \
     } else { \
       NA_LD(ga_,0,12); NA_LD(gb_,1,0); SBAR(); NA_CP(ga_,P0_,0,12); NA_LD(ga_,1,4); SBAR(); NA_CP(gb_,P1_,1,0); NA_LD(gb_,1,8); SBAR(); \
       NA_CP(ga_,P1_,1,4); NA_LD(ga_,1,12); SBAR(); NA_CP(gb_,P1_,1,8); SBAR(); NA_CP(ga_,P1_,1,12); \
       _Pragma("unroll") for(int r=0;r<12;++r)P0_[r]=-INFINITY; \
     } } \
   else { _Pragma("unroll") for(int r=0;r<16;++r){P0_[r]=-INFINITY;P1_[r]=-INFINITY;} } } }while(0)
constexpr int NSLOT=3, SLOTB=8192;
constexpr int LDS_K=0, LDS_V=NSLOT*SLOTB, LDS_WS=2*NSLOT*SLOTB, LDS_OST=LDS_WS+NW*64*4, LDS_BYTES=LDS_OST+NW*4096;
constexpr float C2=0.125f*1.4426950408889634f;
__device__ __forceinline__ void glds16(const void*gsrc,unsigned lds_dst){unsigned keep;
  asm volatile("s_mov_b32 %0, m0\n\ts_mov_b32 m0, %2\n\ts_nop 0\n\tglobal_load_lds_dwordx4 %1, off\n\ts_mov_b32 m0, %0":"=&s"(keep):"v"(gsrc),"s"(lds_dst):"memory");}
__device__ __forceinline__ float max3f(float a,float b,float c){float r;asm("v_max3_f32 %0, %1, %2, %3":"=v"(r):"v"(a),"v"(b),"v"(c));return r;}
__device__ __forceinline__ float max2f(float a,float b){float r;asm("v_max_f32_e32 %0, %1, %2":"=v"(r):"v"(a),"v"(b));return r;}
__device__ __forceinline__ float fadd_s(float a,float b){float r;asm("v_add_f32_e32 %0, %1, %2":"=v"(r):"v"(a),"v"(b));return r;}
__device__ __forceinline__ float fsub_s(float a,float b){float r;asm("v_sub_f32_e32 %0, %1, %2":"=v"(r):"v"(a),"v"(b));return r;}
typedef float f32x2_t __attribute__((ext_vector_type(2))); typedef __bf16 bf16x2_t __attribute__((ext_vector_type(2)));
__device__ __forceinline__ unsigned cvtpk_s(float lo,float hi){f32x2_t v={lo,hi};bf16x2_t b=__builtin_convertvector(v,bf16x2_t);return __builtin_bit_cast(unsigned,b);}
#define WAIT_BAR(N) asm volatile("s_waitcnt vmcnt(" #N ") lgkmcnt(0)\n\ts_barrier":::"memory")

__device__ __forceinline__ void qkt(f32x16&p0,f32x16&p1,const char*Kslot,const bf16x8*qr,const f32x16&negm,int r32,int hi){
  const char*kb=Kslot+hi*1024+r32*16;
  #pragma unroll
  for(int d0=0;d0<4;++d0){
    const bf16x8 b0=*reinterpret_cast<const bf16x8*>(kb+d0*2048);
    const bf16x8 b1=*reinterpret_cast<const bf16x8*>(kb+d0*2048+512);
    if(d0==0){p0=__builtin_amdgcn_mfma_f32_32x32x16_bf16(b0,qr[0],negm,0,0,0);p1=__builtin_amdgcn_mfma_f32_32x32x16_bf16(b1,qr[0],negm,0,0,0);}
    else{p0=__builtin_amdgcn_mfma_f32_32x32x16_bf16(b0,qr[d0],p0,0,0,0);p1=__builtin_amdgcn_mfma_f32_32x32x16_bf16(b1,qr[d0],p1,0,0,0);}}
}
typedef __attribute__((address_space(3))) const char* lds_cptr;
typedef short v4i16_t __attribute__((ext_vector_type(4)));
__device__ __forceinline__ void kload8(bf16x8*kf,lds_cptr kp){
  kf[0]=*(const __attribute__((address_space(3))) bf16x8*)(kp);      kf[1]=*(const __attribute__((address_space(3))) bf16x8*)(kp+512);
  kf[2]=*(const __attribute__((address_space(3))) bf16x8*)(kp+2048); kf[3]=*(const __attribute__((address_space(3))) bf16x8*)(kp+2560);
  kf[4]=*(const __attribute__((address_space(3))) bf16x8*)(kp+4096); kf[5]=*(const __attribute__((address_space(3))) bf16x8*)(kp+4608);
  kf[6]=*(const __attribute__((address_space(3))) bf16x8*)(kp+6144); kf[7]=*(const __attribute__((address_space(3))) bf16x8*)(kp+6656);
}
__device__ __forceinline__ void kload2(bf16x8*kf,lds_cptr kp,int j){ kf[2*j]=*(const __attribute__((address_space(3))) bf16x8*)(kp+j*2048); kf[2*j+1]=*(const __attribute__((address_space(3))) bf16x8*)(kp+j*2048+512); }
__device__ __forceinline__ s16x4 vtr(lds_cptr p){ return __builtin_bit_cast(s16x4,__builtin_amdgcn_ds_read_tr16_b64_v4i16((__attribute__((address_space(3))) v4i16_t*)p)); }
__device__ __forceinline__ float rowmax(const f32x16&p0,const f32x16&p1){
  float a=max3f(p0[0],p0[1],p1[0]),b=max3f(p0[2],p0[3],p1[1]);a=max3f(a,p1[2],p1[3]);
  #pragma unroll
  for(int r=4;r<16;r+=4){a=max3f(a,p0[r],p0[r+1]);b=max3f(b,p0[r+2],p0[r+3]);a=max3f(a,p1[r],p1[r+1]);b=max3f(b,p1[r+2],p1[r+3]);}
  const float m=max2f(a,b);
  auto rr=__builtin_amdgcn_permlane32_swap(__float_as_uint(m),__float_as_uint(m),false,false);
  return max2f(__uint_as_float(rr[0]),__uint_as_float(rr[1]));
}
__device__ __forceinline__ void pv(f32x16*o,int vb,bf16x8 pa0,bf16x8 pa1,bf16x8 pa2,bf16x8 pa3){
  #pragma unroll
  for(int d0=0;d0<2;++d0){s16x4 lo[4],hi[4];
    #pragma unroll
    for(int ks=0;ks<4;++ks){
      asm volatile("ds_read_b64_tr_b16 %0,%1 offset:%c2":"=&v"(lo[ks]):"v"(vb),"i"(d0*4096+ks*1024):"memory");
      asm volatile("ds_read_b64_tr_b16 %0,%1 offset:%c2":"=&v"(hi[ks]):"v"(vb),"i"(d0*4096+ks*1024+512):"memory");}
    asm volatile("s_waitcnt lgkmcnt(0)":::"memory");SBAR();
    #define PK(k) (bf16x8){lo[k][0],lo[k][1],lo[k][2],lo[k][3],hi[k][0],hi[k][1],hi[k][2],hi[k][3]}
    o[d0]=__builtin_amdgcn_mfma_f32_32x32x16_bf16(pa0,PK(0),o[d0],0,0,0);
    o[d0]=__builtin_amdgcn_mfma_f32_32x32x16_bf16(pa1,PK(1),o[d0],0,0,0);
    o[d0]=__builtin_amdgcn_mfma_f32_32x32x16_bf16(pa2,PK(2),o[d0],0,0,0);
    o[d0]=__builtin_amdgcn_mfma_f32_32x32x16_bf16(pa3,PK(3),o[d0],0,0,0);
    #undef PK
  }
}

template<int THRL,bool NA> __device__ __forceinline__ int attn_unit(const bf16*Qu,bf16*Ou,int qp,const bf16*__restrict__ Kh,const bf16*__restrict__ Vh,int kp,int NT,char*shm,
    const float*__restrict__ rpbh,int b0,int qrow0,int nrows,const int wave_s,const int s0b,const bool pre,const bf16*__restrict__ nKh,const bf16*__restrict__ nVh){
  int tid_=(wave_s<<6)|lane_now(); asm volatile("":"+v"(tid_)); const int tid=tid_,lane=tid&63,r32=lane&31,hi=lane>>5; const int wid=__builtin_amdgcn_readfirstlane(tid>>6);
  const bf16*Qw=Qu+(long)(wid*QBLK)*qp;
  const unsigned lds0=(unsigned)(uintptr_t)shm;
  float*wsf=(float*)(shm+LDS_WS)+wid*64;
  const bf16*ksrc=Kh+(long)lane*kp+wid*8;
  const bf16*vsrc=Vh+(long)(16*(wid&3)+(lane>>2))*kp+(wid>>2)*32+(lane&3)*8;
  const unsigned kdst=lds0+LDS_K+wid*1024, vdst=lds0+LDS_V+wid*1024;
  #define DMA_K(t,slot) glds16(ksrc+(long)(t)*KVBLK*kp,(unsigned)__builtin_amdgcn_readfirstlane(kdst+(slot)))
  #define DMA_V(t,slot) glds16(vsrc+(long)(t)*KVBLK*kp,(unsigned)__builtin_amdgcn_readfirstlane(vdst+(slot)))
  const int vb0=(int)(lds0+LDS_V)+((lane>>4)&1)*32+(lane&3)*8+(4*hi+((lane&15)>>2))*64;
  const char*Kbase=shm+LDS_K; bf16x8 kf[8];
  const lds_cptr shm3=(lds_cptr)shm; const lds_cptr kp0=shm3+LDS_K+hi*1024+r32*16; const lds_cptr vp0=shm3+LDS_V+((lane>>4)&1)*32+(lane&3)*8+(4*hi+((lane&15)>>2))*64;
  #define NXS(x) (((x)==(NSLOT-1)*SLOTB)?0:(x)+SLOTB)
  const int s1b=NXS(s0b),s2b=NXS(s1b);
  if(!pre){DMA_K(0,s0b);DMA_V(0,s0b);DMA_K(1,s1b);}
  bf16x8 qr[4];
  #pragma unroll
  for(int d0=0;d0<4;++d0)qr[d0]=*reinterpret_cast<const bf16x8*>(&Qw[(long)r32*qp+d0*16+hi*8]);
  float mhat=0.f,l_reg=0.f;f32x16 o[2];o[0]=f32x16{};o[1]=f32x16{};f32x16 negm=f32x16{};if constexpr(!NA&&THRL>=0){asm volatile("":"+v"(negm));}
  NA_SETUP
  #define NEGMC ((NA||THRL<0)?f32x16{}:negm)
  #define CMASK(P0,P1,t) NAMASK(P0,P1,t)
  bool resc=false;
  #define START(P0,P1) do{ resc=false; \
    if constexpr(THRL>=0){ const float rm=rowmax(P0,P1); const float dl=NA?__builtin_fmaxf(rm,-1000.f):rm; mhat=fadd_s(mhat,dl); \
      _Pragma("unroll") for(int r=0;r<16;++r){P0[r]=fsub_s(P0[r],dl);P1[r]=fsub_s(P1[r],dl);} \
      if constexpr(!NA){_Pragma("unroll") for(int r=0;r<16;++r)negm[r]=-mhat; asm volatile("":"+v"(negm));} } \
    _Pragma("unroll") for(int r=0;r<16;++r)P0[r]=__builtin_amdgcn_exp2f(P0[r]); }while(0)
  #define RESC() do{ if(resc){ asm volatile("s_waitcnt lgkmcnt(0)":::"memory"); \
      _Pragma("unroll") for(int d_=0;d_<2;++d_) _Pragma("unroll") for(int r=0;r<16;++r)o[d_][r]*=wsf[crow(r,hi)]; } }while(0)
  f32x16 pA0,pA1,pB0,pB1;
  int sl_prev=s0b,sl_cur=s0b,sl_next=s1b;
  #define ROT() do{sl_prev=sl_cur;sl_cur=sl_next;sl_next=(sl_next==(NSLOT-1)*SLOTB)?0:sl_next+SLOTB;}while(0)
  if(!pre){DMA_K(2,s2b);}
  WAIT_BAR(3);
  if constexpr(NA||THRL<0){const f32x16 z_=f32x16{};qkt(pA0,pA1,Kbase+s0b,qr,z_,r32,hi);}else{qkt(pA0,pA1,Kbase+s0b,qr,negm,r32,hi);}asm volatile("s_nop 15\n\ts_nop 7":"+v"(pA0),"+v"(pA1));CMASK(pA0,pA1,0);
  START(pA0,pA1);
  _Pragma("unroll") for(int r=0;r<16;++r)pA1[r]=__builtin_amdgcn_exp2f(pA1[r]);
  WAIT_BAR(0);
  DMA_K(3,s0b);DMA_V(1,s1b);
  ROT();
  kload8(kf,kp0+sl_cur);
  WAIT_BAR(2);
  s16x4 vlo[8],vhi[8]; u32x4 pw0,pw1,pw2,pw3;
  #define PKW(P,B) cvtpk_s(P[B],P[B+1])
  #define PAF(k) __builtin_bit_cast(bf16x8,pw##k)
  #define VFR(i) (bf16x8){vlo[i][0],vlo[i][1],vlo[i][2],vlo[i][3],vhi[i][0],vhi[i][1],vhi[i][2],vhi[i][3]}
  #define PIN(x) asm volatile("":"+v"(x))
  #define MX3(a,b,c) __builtin_fmaxf(__builtin_fmaxf((a),(b)),(c))
  #define GAPA(MF,A0,A1,A2,A3,W0,W1,PW) do{ MF; sacc+=A0; sacc+=A1; sacc+=A2; sacc+=A3; PIN(sacc); W0; W1; PIN(PW); SBAR(); }while(0)
  #define EX(v) __builtin_amdgcn_exp2f(v)
  #define GAPB(MF,X,B) do{ MF; X[B]=EX(X[B]); X[B+1]=EX(X[B+1]); X[B+2]=EX(X[B+2]); X[B+3]=EX(X[B+3]); PIN(X); SBAR(); }while(0)
  #define VRD(i) do{ vlo[i]=vtr(vp_+(((i)>>2)*4096+((i)&3)*1024)); vhi[i]=vtr(vp_+(((i)>>2)*4096+((i)&3)*1024+512)); }while(0)
  #define KRD(G,j) do{ if(G){ kload2(kf,kp0+sl_next,j); SBAR(); } }while(0)
  #define STEP(C0,C1,P0,P1,t,GK,GV,GL) do{ SBAR(); \
    const lds_cptr vp_=vp0+sl_prev; \
    VRD(0); SBAR(); float sacc=(P0[0]+P0[1]); \
    GAPA(C0=__builtin_amdgcn_mfma_f32_32x32x16_bf16(kf[0],qr[0],NEGMC,0,0,0), P0[2],P0[3],P0[4],P0[5],     pw0[0]=PKW(P0,0), pw0[1]=PKW(P0,2), pw0); \
    VRD(4); SBAR(); GAPA(C1=__builtin_amdgcn_mfma_f32_32x32x16_bf16(kf[1],qr[0],NEGMC,0,0,0), P0[6],P0[7],P0[8],P0[9],     pw0[2]=PKW(P0,4), pw0[3]=PKW(P0,6), pw0); \
    VRD(1); SBAR(); GAPA(C0=__builtin_amdgcn_mfma_f32_32x32x16_bf16(kf[2],qr[1],C0,0,0,0),   P0[10],P0[11],P0[12],P0[13], pw1[0]=PKW(P0,8), pw1[1]=PKW(P0,10), pw1); \
    VRD(5); SBAR(); GAPA(C1=__builtin_amdgcn_mfma_f32_32x32x16_bf16(kf[3],qr[1],C1,0,0,0),   P0[14],P0[15],P1[0],P1[1],   pw1[2]=PKW(P0,12),pw1[3]=PKW(P0,14), pw1); \
    VRD(2); SBAR(); GAPA(C0=__builtin_amdgcn_mfma_f32_32x32x16_bf16(kf[4],qr[2],C0,0,0,0),   P1[2],P1[3],P1[4],P1[5],     pw2[0]=PKW(P1,0), pw2[1]=PKW(P1,2), pw2); \
    VRD(6); SBAR(); GAPA(C1=__builtin_amdgcn_mfma_f32_32x32x16_bf16(kf[5],qr[2],C1,0,0,0),   P1[6],P1[7],P1[8],P1[9],     pw2[2]=PKW(P1,4), pw2[3]=PKW(P1,6), pw2); \
    VRD(3); SBAR(); GAPA(C0=__builtin_amdgcn_mfma_f32_32x32x16_bf16(kf[6],qr[3],C0,0,0,0),   P1[10],P1[11],P1[12],P1[13], pw3[0]=PKW(P1,8), pw3[1]=PKW(P1,10), pw3); \
    VRD(7); SBAR(); GAPA(C1=__builtin_amdgcn_mfma_f32_32x32x16_bf16(kf[7],qr[3],C1,0,0,0),   P1[14],P1[15],0.f,0.f,       pw3[2]=PKW(P1,12),pw3[3]=PKW(P1,14), pw3); \
    l_reg+=sacc; \
    if(GK){DMA_K((t)+3,sl_cur);} if(GV){DMA_V((t)+1,sl_next);} \
    CMASK(C0,C1,t); \
    resc=false; if constexpr(THRL>=0){ float a=MX3(C0[0],C0[1],C1[0]),b=MX3(C0[2],C0[3],C1[1]); a=MX3(a,C1[2],C1[3]); \
      _Pragma("unroll") for(int r=4;r<16;r+=4){a=MX3(a,C0[r],C0[r+1]);b=MX3(b,C0[r+2],C0[r+3]);a=MX3(a,C1[r],C1[r+1]);b=MX3(b,C1[r+2],C1[r+3]);} \
      float rm=__builtin_fmaxf(a,b); { auto rr=__builtin_amdgcn_permlane32_swap(__float_as_uint(rm),__float_as_uint(rm),false,false); rm=__builtin_fmaxf(__uint_as_float(rr[0]),__uint_as_float(rr[1])); } \
      resc=false; \
      if(__builtin_expect(__any(rm>(float)THRL),0)){ const float dl=__builtin_fmaxf(rm,0.f); mhat+=dl; \
        _Pragma("unroll") for(int r=0;r<16;++r){C0[r]-=dl;C1[r]-=dl;} \
        if constexpr(!NA){_Pragma("unroll") for(int r=0;r<16;++r)negm[r]=-mhat; asm volatile("":"+v"(negm));} \
        const float f=__builtin_amdgcn_exp2f(-dl); l_reg*=f; { const int l_=lane_now(); if(l_<32)wsf[l_]=f; } resc=true; } } \
    SBAR(); \
    GAPB(o[0]=__builtin_amdgcn_mfma_f32_32x32x16_bf16(PAF(0),VFR(0),o[0],0,0,0), C0,0); \
    GAPB(o[1]=__builtin_amdgcn_mfma_f32_32x32x16_bf16(PAF(0),VFR(4),o[1],0,0,0), C0,4); \
    KRD(GL,0); GAPB(o[0]=__builtin_amdgcn_mfma_f32_32x32x16_bf16(PAF(1),VFR(1),o[0],0,0,0), C0,8); \
    KRD(GL,1); GAPB(o[1]=__builtin_amdgcn_mfma_f32_32x32x16_bf16(PAF(1),VFR(5),o[1],0,0,0), C0,12); \
    KRD(GL,2); GAPB(o[0]=__builtin_amdgcn_mfma_f32_32x32x16_bf16(PAF(2),VFR(2),o[0],0,0,0), C1,0); \
    KRD(GL,3); GAPB(o[1]=__builtin_amdgcn_mfma_f32_32x32x16_bf16(PAF(2),VFR(6),o[1],0,0,0), C1,4); \
    GAPB(o[0]=__builtin_amdgcn_mfma_f32_32x32x16_bf16(PAF(3),VFR(3),o[0],0,0,0), C1,8); \
    GAPB(o[1]=__builtin_amdgcn_mfma_f32_32x32x16_bf16(PAF(3),VFR(7),o[1],0,0,0), C1,12); \
    }while(0)
  int t=1;
  for(;t+5<NT;t+=2){
    STEP(pB0,pB1,pA0,pA1,t,true,true,true);     WAIT_BAR(2); RESC(); ROT();
    STEP(pA0,pA1,pB0,pB1,t+1,true,true,true);   WAIT_BAR(2); RESC(); ROT();
  }
  #define ENDW(tt) do{ if((tt)+3<NT){WAIT_BAR(2);} else if((tt)+2<NT){WAIT_BAR(1);} else {WAIT_BAR(0);} }while(0)
  for(;t+1<NT;t+=2){
    STEP(pB0,pB1,pA0,pA1,t,(t+3<NT),(t+1<NT),(t+1<NT));       ENDW(t);   RESC(); ROT();
    STEP(pA0,pA1,pB0,pB1,t+1,(t+4<NT),(t+2<NT),(t+2<NT));     ENDW(t+1); RESC(); ROT();
  }
  STEP(pB0,pB1,pA0,pA1,NT-1,false,false,false); RESC();
  if(nKh){ const bf16*nks=nKh+(long)lane*kp+wid*8; const bf16*nvs=nVh+(long)(16*(wid&3)+(lane>>2))*kp+(wid>>2)*32+(lane&3)*8; const int n1=NXS(sl_next),n2=NXS(n1);
    glds16(nks,(unsigned)__builtin_amdgcn_readfirstlane(kdst+sl_next)); glds16(nvs,(unsigned)__builtin_amdgcn_readfirstlane(vdst+sl_next));
    glds16(nks+(long)KVBLK*kp,(unsigned)__builtin_amdgcn_readfirstlane(kdst+n1)); glds16(nks+(long)2*KVBLK*kp,(unsigned)__builtin_amdgcn_readfirstlane(kdst+n2)); }
  { float sacc=pB0[0]+pB0[1]; _Pragma("unroll") for(int r=2;r<16;++r)sacc+=pB0[r]; _Pragma("unroll") for(int r=0;r<16;++r)sacc+=pB1[r]; l_reg+=sacc;
    pw0=(u32x4){PKW(pB0,0),PKW(pB0,2),PKW(pB0,4),PKW(pB0,6)};pw1=(u32x4){PKW(pB0,8),PKW(pB0,10),PKW(pB0,12),PKW(pB0,14)};pw2=(u32x4){PKW(pB1,0),PKW(pB1,2),PKW(pB1,4),PKW(pB1,6)};pw3=(u32x4){PKW(pB1,8),PKW(pB1,10),PKW(pB1,12),PKW(pB1,14)};
    SBAR(); pv(o,vb0+sl_cur,PAF(0),PAF(1),PAF(2),PAF(3)); }
  #undef PKW
  #undef PAF
  #undef VFR
  #undef PIN
  #undef MX3
  #undef GAPA
  #undef GAPB
  #undef EX
  #undef VRD
  #undef KRD
  #undef STEP
  #undef ENDW
  {auto rr=__builtin_amdgcn_permlane32_swap(__float_as_uint(l_reg),__float_as_uint(l_reg),false,false);l_reg=__uint_as_float(rr[0])+__uint_as_float(rr[1]);}
  if(hi==0)wsf[32+r32]=l_reg;asm volatile("s_waitcnt lgkmcnt(0)":::"memory");
  float rli[16];
  #pragma unroll
  for(int r=0;r<16;++r)rli[r]=__builtin_amdgcn_rcpf(wsf[32+crow(r,hi)]);
  bf16*Ow=Ou+(long)(wid*QBLK)*qp;
  { bf16*stg=(bf16*)(shm+LDS_OST)+wid*2048;
    #pragma unroll
    for(int r=0;r<16;++r){const int orow=crow(r,hi);
      #pragma unroll
      for(int d0=0;d0<2;++d0)stg[orow*64+d0*32+r32]=__float2bfloat16(o[d0][r]*rli[r]);}
    asm volatile("s_waitcnt lgkmcnt(0)":::"memory");
    { const __amdgpu_buffer_rsrc_t orsrc=__builtin_amdgcn_make_buffer_rsrc((void*)Ow,(short)0,32*qp*2,0x00020000);
    #pragma unroll
    for(int i=0;i<4;++i){const int row=i*8+(lane>>3),ch=lane&7; const u32x4 v=*(const u32x4*)(stg+row*64+ch*8); __builtin_amdgcn_raw_buffer_store_b128(v,orsrc,(unsigned)((row*qp+ch*8)*2),0,16);} } }
  asm volatile("s_waitcnt lgkmcnt(0)\n\ts_barrier":::"memory");
  const int ret_slot=sl_next;
  #undef NXS
  #undef DMA_K
  #undef DMA_V
  #undef CMASK
  #undef START
  #undef RESC
  #undef ROT
  return ret_slot;
}
struct NaUnit { size_t qoff, koff; int lo, nt, h, qb, rows; bool ok; };
__device__ __forceinline__ NaUnit na_unit_of(int li, int vcu, int perP, int perS, int nP, int nS) {
  NaUnit u; u.ok = false; u.qoff = 0; u.koff = 0; u.lo = 0; u.nt = 0; u.h = 0; u.qb = 0; u.rows = 0;
  if (li >= perP + perS) return u;
  const bool isP = li < perP; const int idx = isP ? vcu * perP + li : vcu * perS + (li - perP);
  if (idx >= (isP ? nP : nS)) return u;
  const int nqb = isP ? 16 : 8, rows = isP ? 64 : 32, S = rows * 64; const int bh = idx / nqb, qb = idx % nqb, b = bh >> 3, h = bh & 7;
  const size_t rb = (isP ? (size_t)0 : (size_t)(8 * 4096)) + (size_t)b * S;
  int lo = 4 * qb - 4; lo = lo < 0 ? 0 : lo; lo = lo > rows - 8 ? rows - 8 : lo; int hi_ = 4 * qb - 1; hi_ = hi_ < 0 ? 0 : hi_; hi_ = hi_ > rows - 8 ? rows - 8 : hi_; hi_ += 8;
  int nt = hi_ - lo; nt += nt & 1; if (lo + nt > rows) lo = rows - nt;
  u.ok = true; u.qoff = (rb + (size_t)qb * 256) * 1024 + 512 + h * 64; u.koff = (rb + (size_t)lo * 64) * 512 + h * 64; u.lo = lo; u.nt = nt; u.h = h; u.qb = qb; u.rows = rows;
  return u;
}
constexpr int ATTN_LDS_BYTES=LDS_BYTES;
#undef SBAR
#undef WAIT_BAR
#undef NA_SETUP
#undef NAMASK
#undef NA_LD
#undef NA_CP
}

#ifndef PROBE_DUP
#define PROBE_DUP 0
#endif
#ifndef PH_MASK
#define PH_MASK 255
#endif
constexpr int NWAVES = 8;
constexpr int DMODEL = 1024, MP = 8 * 4096, MS = 32 * 2048, MTOK = MP + MS, NIN = 4352, FF = 4096;
constexpr size_t MiB = 1u << 20;
constexpr size_t WS_SS = 0, WS_SS2 = 1 * MiB, WS_ROPE = 2 * MiB, WS_BAR = 3 * MiB;
constexpr int MISC_OFF = 131072 + 320;
constexpr size_t WS_WIN = 4 * MiB, WS_WP = 13 * MiB, WS_WO = 15 * MiB, WS_WUP = 17 * MiB, WS_WDN = 25 * MiB;
constexpr size_t WS_QAB = 40 * MiB, WS_KAVA = 232 * MiB, WS_KB = 280 * MiB, WS_VB = 376 * MiB, WS_G = 472 * MiB, WS_U = 232 * MiB, WS_MG = 280 * MiB, WS_HB = 40 * MiB, WS_END = 1000 * MiB;
static_assert(WS_WIN + (size_t)NIN * 1024 * 2 <= WS_WP && WS_WDN + (size_t)FF * 1024 * 2 <= WS_QAB, "weights map");
static_assert(WS_QAB + (size_t)MTOK * 1024 * 2 == WS_KAVA && WS_KAVA + (size_t)MTOK * 256 * 2 == WS_KB && WS_KB + (size_t)MTOK * 512 * 2 == WS_VB && WS_VB + (size_t)MTOK * 512 * 2 == WS_G, "activation map");
static_assert(WS_G + (size_t)MTOK * 2048 * 2 <= WS_END && WS_U + (size_t)MTOK * 4096 * 2 <= WS_END, "ws end");
constexpr int LDS_BYTES = 147456;

#define GAS __attribute__((address_space(1)))
#define LAS __attribute__((address_space(3)))
typedef unsigned short bf16;
typedef unsigned v4u __attribute__((ext_vector_type(4)));
typedef float f32x4 __attribute__((ext_vector_type(4)));
#define LDS_WAIT() asm volatile("s_waitcnt lgkmcnt(0)" ::: "memory")
typedef GAS unsigned gu32;
#define RLX_AGENT __ATOMIC_RELAXED, __HIP_MEMORY_SCOPE_AGENT
#define XB_TMO      128
#define XB_XCNT(j)  (256  + 64 * (j))
#define XB_XSUB(j)  (1280 + 64 * (j))
#define XB_XGEN(j)  (2304 + 64 * (j))
#define XB_TOP      3328
#define XB_TOPGEN   3392
#define XCD_BAR_WORDS 3456
#define XB_SPIN_CAP (1u << 18)

__device__ __forceinline__ unsigned xb_ld(unsigned* p)              { return __hip_atomic_load(p, __ATOMIC_RELAXED, __HIP_MEMORY_SCOPE_AGENT); }
__device__ __forceinline__ unsigned xb_add(unsigned* p, unsigned v) { return __hip_atomic_fetch_add(p, v, __ATOMIC_RELAXED, __HIP_MEMORY_SCOPE_AGENT); }
__device__ __forceinline__ unsigned xb_xcc_id() { return (unsigned)__builtin_amdgcn_s_getreg((3 << 11) | 20) & 0xFu; }
#define XB_SPIN(cond, bar) do { unsigned _sp = 0; while (cond) { __builtin_amdgcn_s_sleep(1); \
    if ((++_sp & 255u) == 0u) { if (xb_ld(&(bar)[XB_TMO])) break; if (_sp > XB_SPIN_CAP) { atomicAdd(&(bar)[XB_TMO], 1u); break; } } } } while (0)

struct XcdBarrier {
    unsigned* bar; unsigned x; int wave;
    volatile LAS unsigned* st;
};

__device__ __forceinline__ XcdBarrier xcd_barrier_post(unsigned* bar, volatile LAS unsigned* st, int wave) {
    XcdBarrier b; b.bar = bar; b.x = xb_xcc_id(); b.st = st; b.wave = wave;
    if (wave == 0 && lane_now() == 0) (void)xb_add(&bar[XB_XCNT(b.x)], 1u);
    return b;
}
__device__ __forceinline__ void xcd_barrier_complete(unsigned* bar, unsigned x, unsigned& nloc, unsigned& nx) {
    const unsigned G = gridDim.x * gridDim.y * gridDim.z;
    unsigned sum, cnt, mine, sp = 0u;
    for (;;) {
        sum = 0u; cnt = 0u; mine = 0u;
#pragma unroll
        for (unsigned j = 0; j < 16; ++j) { const unsigned c = xb_ld(&bar[XB_XCNT(j)]); sum += c; cnt += (c > 0u) ? 1u : 0u; mine = (j == x) ? c : mine; }
        if (sum == G) break;
        __builtin_amdgcn_s_sleep(1);
        if ((++sp & 255u) == 0u) { if (xb_ld(&bar[XB_TMO])) break; if (sp > XB_SPIN_CAP) { atomicAdd(&bar[XB_TMO], 1u); break; } }
    }
    nloc = mine > 0u ? mine : 1u; nx = cnt > 0u ? cnt : 1u;
}

__device__ __forceinline__ void xcd_barrier(const XcdBarrier& b) {
    asm volatile("s_waitcnt vmcnt(0)" ::: "memory");
    __syncthreads();
    if (b.wave == 0 && lane_now() == 0) {
        unsigned* bar = b.bar;
        __builtin_amdgcn_s_waitcnt(0);
        unsigned nloc = b.st[0], nx = b.st[1];
        if (nloc == 0u) { xcd_barrier_complete(bar, b.x, nloc, nx); b.st[0] = nloc; b.st[1] = nx; }
        const unsigned old = xb_add(&bar[XB_XSUB(b.x)], 1u);
        const unsigned gen = old / nloc;
        if (old + 1u == (gen + 1u) * nloc) {
            __builtin_amdgcn_fence(__ATOMIC_RELEASE, "agent");
            asm volatile("s_waitcnt vmcnt(0)" ::: "memory");
            const unsigned og = xb_add(&bar[XB_TOP], 1u);
            const unsigned tg = og / nx;
            if (og + 1u == (tg + 1u) * nx) xb_add(&bar[XB_TOPGEN], 1u);
            else XB_SPIN(xb_ld(&bar[XB_TOPGEN]) == tg, bar);
            __builtin_amdgcn_fence(__ATOMIC_ACQUIRE, "agent");
            xb_add(&bar[XB_XGEN(b.x)], 1u);
            asm volatile("s_waitcnt vmcnt(0)" ::: "memory");
        } else {
            XB_SPIN(xb_ld(&bar[XB_XGEN(b.x)]) == gen, bar);
            __builtin_amdgcn_fence(__ATOMIC_ACQUIRE, "agent");
            asm volatile("s_waitcnt vmcnt(0)" ::: "memory");
        }
    }
    __syncthreads();
}

__device__ __forceinline__ float wave_sum(float v) {
#pragma unroll
    for (int o = 1; o < 64; o <<= 1) v += __shfl_xor(v, o);
    return v;
}
__device__ __forceinline__ void tr_item(const float* W, int N, int k0, int n0, bf16* WT, int ldt, int drow0, int dk0, const float* kscale, LAS float* scr, int lane) {
    float wv[32];
#pragma unroll
    for (int i = 0; i < 32; ++i) { const int kk = 2 * i + (lane >> 5); wv[i] = __builtin_nontemporal_load(W + (size_t)(k0 + kk) * N + n0 + (lane & 31)); }
#pragma unroll
    for (int i = 0; i < 32; ++i) { const int kk = 2 * i + (lane >> 5); float w = wv[i]; if (kscale) w *= kscale[k0 + kk]; scr[kk * 33 + (lane & 31)] = w; }
    LDS_WAIT(); asm volatile("" ::: "memory");
    const int c = lane & 7;
#pragma unroll
    for (int j = 0; j < 4; ++j) { const int n = (lane >> 3) + 8 * j; const LAS float* s = scr + (8 * c) * 33 + n;
        v4u o; o.x = pg8::pkbf(s[0 * 33], s[1 * 33]); o.y = pg8::pkbf(s[2 * 33], s[3 * 33]); o.z = pg8::pkbf(s[4 * 33], s[5 * 33]); o.w = pg8::pkbf(s[6 * 33], s[7 * 33]);
        *(GAS v4u*)(WT + (size_t)(drow0 + n) * ldt + dk0 + 8 * c) = o; }
    LDS_WAIT(); asm volatile("" ::: "memory");
}
__device__ __forceinline__ void rms_row_to_bf16(const float* xrow, const float* g, bf16* orow, int lane) {
    const GAS f32x4* xr = (const GAS f32x4*)xrow + lane; const GAS f32x4* gr = (const GAS f32x4*)g + lane;
    f32x4 v[4]; float s = 0.f;
#pragma unroll
    for (int j = 0; j < 4; ++j) { v[j] = xr[64 * j]; s += pg8::sumsq4(v[j]); }
    const float rstd = __builtin_amdgcn_rsqf(wave_sum(s) * (1.f / 1024.f) + 1e-6f);
    GAS unsigned long long* o8 = (GAS unsigned long long*)orow + lane;
#pragma unroll
    for (int j = 0; j < 4; ++j) { const f32x4 gg = gr[64 * j]; const f32x4 y = v[j] * rstd * gg; o8[64 * j] = (unsigned long long)pg8::pkbf(y[0], y[1]) | ((unsigned long long)pg8::pkbf(y[2], y[3]) << 32); }
}
__device__ __forceinline__ void cvt_row2_to_bf16(const float* xa, const float* xb, bf16* oa, bf16* ob, float* sa_out, float* sb_out, int lane) {
    const GAS f32x4* ra = (const GAS f32x4*)xa + lane; const GAS f32x4* rb = (const GAS f32x4*)xb + lane;
    f32x4 va[4], vb[4]; float sa = 0.f, sb = 0.f;
#pragma unroll
    for (int j = 0; j < 4; ++j) { va[j] = __builtin_nontemporal_load(ra + 64 * j); vb[j] = __builtin_nontemporal_load(rb + 64 * j); }
    GAS unsigned long long* pa = (GAS unsigned long long*)oa + lane; GAS unsigned long long* pb = (GAS unsigned long long*)ob + lane;
#pragma unroll
    for (int j = 0; j < 4; ++j) { sa += pg8::sumsq4(va[j]); sb += pg8::sumsq4(vb[j]);
        pa[64 * j] = (unsigned long long)pg8::pkbf(va[j][0], va[j][1]) | ((unsigned long long)pg8::pkbf(va[j][2], va[j][3]) << 32);
        pb[64 * j] = (unsigned long long)pg8::pkbf(vb[j][0], vb[j][1]) | ((unsigned long long)pg8::pkbf(vb[j][2], vb[j][3]) << 32); }
#pragma unroll
    for (int o = 1; o < 64; o <<= 1) { sa += __shfl_xor(sa, o); sb += __shfl_xor(sb, o); }
    if (lane == 0) { *sa_out = sa; *sb_out = sb; }
}
__device__ __forceinline__ void final_row(const bf16* hrow, float* orow, const float* g, float ssum, int lane) {
    const float rs = __builtin_amdgcn_rsqf(ssum * (1.f / 1024.f) + 1e-6f);
#pragma unroll
    for (int j = 0; j < 2; ++j) { const v4u h = *((const GAS v4u*)hrow + lane + 64 * j); const int c = (lane + 64 * j) * 8;
        const f32x4 g0 = *(const GAS f32x4*)(g + c), g1 = *(const GAS f32x4*)(g + c + 4);
        f32x4 a, b; a[0] = pg8::bflo(h.x); a[1] = pg8::bfhi(h.x); a[2] = pg8::bflo(h.y); a[3] = pg8::bfhi(h.y); b[0] = pg8::bflo(h.z); b[1] = pg8::bfhi(h.z); b[2] = pg8::bflo(h.w); b[3] = pg8::bfhi(h.w);
        *(GAS f32x4*)(orow + c) = a * rs * g0; *(GAS f32x4*)(orow + c + 4) = b * rs * g1; }
}

struct Args { const float* in[14]; float* out; unsigned char* ws; unsigned long long never; };

__global__ void __launch_bounds__(NWAVES * 64, 2) fwd_kernel(Args args) {
    extern __shared__ __attribute__((aligned(16))) unsigned char lds[];
    cg::grid_group grid = cg::this_grid();
    LAS unsigned char* ldsp = (LAS unsigned char*)lds;
    const int wave = __builtin_amdgcn_readfirstlane((int)threadIdx.x >> 6);
    const int G = gridDim.x; const int bx = blockIdx.x; const int vcu = (G % 8 == 0) ? (bx % 8) * (G / 8) + bx / 8 : bx;
    unsigned char* ws = args.ws;
    float* ss = (float*)(ws + WS_SS); float* ss2 = (float*)(ws + WS_SS2); float* ssx = (float*)(ws + WS_SS2 + 512 * 1024); float* rope = (float*)(ws + WS_ROPE);
    bf16* Win_t = (bf16*)(ws + WS_WIN); bf16* Wp_t = (bf16*)(ws + WS_WP); bf16* Wo_t = (bf16*)(ws + WS_WO); bf16* Wup_t = (bf16*)(ws + WS_WUP); bf16* Wdn_t = (bf16*)(ws + WS_WDN);
    bf16* QAB = (bf16*)(ws + WS_QAB); bf16* KAVA = (bf16*)(ws + WS_KAVA); bf16* KB = (bf16*)(ws + WS_KB); bf16* VB = (bf16*)(ws + WS_VB); bf16* GT = (bf16*)(ws + WS_G);
    bf16* U = (bf16*)(ws + WS_U); bf16* MG = (bf16*)(ws + WS_MG); bf16* HB = (bf16*)(ws + WS_HB);
    float* out = args.out; bf16* XN = (bf16*)out;
    volatile LAS unsigned* MISC = (volatile LAS unsigned*)(ldsp + MISC_OFF);
    if (wave == 0 && lane_now() < 32) MISC[lane_now()] = 0u;
    __syncthreads();
    unsigned* barw = (unsigned*)(ws + WS_BAR);
    if (args.never != 0) grid.sync();
    const XcdBarrier xbar = xcd_barrier_post(barw, MISC + 8, wave);

#if PH_MASK & (1 << 0)
    {
        int tid = (wave << 6) | lane_now(); asm volatile("" : "+v"(tid)); const int lane = tid & 63;
        const int gw = vcu * NWAVES + wave, NGW = G * NWAVES;
        for (int i = bx * 512 + tid; i < MTOK; i += G * 512) { ss[i] = 0.f; ss2[i] = 0.f; }
        if (bx == 0 && tid < 16) {
            double th = 1.0; for (int j = 0; j < tid; ++j) th *= 0.5623413251903491;
            double c1 = 1.0, s1 = th, tc = 1.0, tsn = th; const double t2 = th * th;
            for (int k = 1; k < 14; ++k) { tc = -tc * t2 / (double)((2 * k - 1) * (2 * k)); tsn = -tsn * t2 / (double)((2 * k) * (2 * k + 1)); c1 += tc; s1 += tsn; }
            double c = 1.0, s = 0.0;
            for (int p = 0; p < 64; ++p) { rope[(p * 16 + tid) * 2] = (float)c; rope[(p * 16 + tid) * 2 + 1] = (float)s; const double cn = c * c1 - s * s1, sn = s * c1 + c * s1; c = cn; s = sn; }
        }
        LAS float* scr = (LAS float*)(ldsp + wave * 16384);
        constexpr int I_IN = 16 * (NIN / 32), I_PA = 8 * 32, I_PB = 8 * 32, I_O = 16 * 32, I_UP = 16 * (FF / 32), I_DN = 64 * 32;
        constexpr int NITEMS = I_IN + I_PA + I_PB + I_O + I_UP + I_DN;
        for (int it = gw; it < NITEMS; it += NGW) {
            int r = it;
            if (r < I_IN) { const int nb = r % (NIN / 32), kb = r / (NIN / 32); const int n0 = nb * 32; int d0 = n0;
                if (n0 < 768) { const int pn = n0 >> 8, rem = n0 & 255, wc = rem >> 6, bj = (rem & 63) >> 5; d0 = 256 * pn + 128 * bj + 32 * wc; }
                else if (n0 >= 2304) { const int isb = n0 >= 3328, c0 = n0 - (isb ? 3328 : 2304); d0 = 2304 + 256 * (c0 >> 7) + 128 * isb + (c0 & 127); }
                tr_item(args.in[3], NIN, kb * 64, n0, Win_t, 1024, d0, kb * 64, args.in[2], scr, lane); continue; } r -= I_IN;
            if (r < I_PA) { const int nb = r % 32, kb = r / 32; tr_item(args.in[7], 1024, kb * 64, nb * 32, Wp_t, 1024, nb * 32, kb * 64, nullptr, scr, lane); continue; } r -= I_PA;
            if (r < I_PB) { const int nb = r % 32, kb = r / 32; tr_item(args.in[8], 1024, kb * 64, nb * 32, Wp_t, 1024, nb * 32, 512 + kb * 64, nullptr, scr, lane); continue; } r -= I_PB;
            if (r < I_O) { const int nb = r % 32, kb = r / 32; tr_item(args.in[9], 1024, kb * 64, nb * 32, Wo_t, 1024, nb * 32, kb * 64, nullptr, scr, lane); continue; } r -= I_O;
            if (r < I_UP) { const int nb = r % (FF / 32), kb = r / (FF / 32); tr_item(args.in[11], FF, kb * 64, nb * 32, Wup_t, 1024, nb * 32, kb * 64, args.in[10], scr, lane); continue; } r -= I_UP;
            { const int nb = r % 32, kb = r / 32; tr_item(args.in[12], 1024, kb * 64, nb * 32, Wdn_t, FF, nb * 32, kb * 64, nullptr, scr, lane); }
        }
        for (int m = gw; m < MTOK; m += 2 * NGW) {
            const int m2 = m + NGW; const bool two = m2 < MTOK; const int mb = two ? m2 : m;
            const float* xa = m < MP ? args.in[0] + (size_t)m * 1024 : args.in[1] + (size_t)(m - MP) * 1024;
            const float* xb = mb < MP ? args.in[0] + (size_t)mb * 1024 : args.in[1] + (size_t)(mb - MP) * 1024;
            cvt_row2_to_bf16(xa, xb, XN + (size_t)m * 1024, XN + (size_t)mb * 1024, ssx + m, ssx + mb, lane); }
    }
#endif
    xcd_barrier(xbar);

#if PH_MASK & (1 << 1)
    {
        pg8::Gemm g{XN, Win_t, 1024, 1024, MTOK, NIN, 1024}; pg8::StaticOrder S; S.init(MTOK, NIN, G, bx); S.rev = true;
        pg8::EpiIn E{QAB, KAVA, KB, VB, GT, args.in[4], args.in[5], rope, ssx};
        pg8::gemm_phase<pg8::EpiIn, pg8::StaticOrder, true, true>(ldsp, g, S, E, wave);
    }
#endif
    xcd_barrier(xbar);

#if PH_MASK & (1 << 2)
    {
        using attn_body::bf16; const bf16* q = (const bf16*)QAB; bf16* o = (bf16*)QAB; const bf16* kava = (const bf16*)KAVA; const bf16* kb_ = (const bf16*)KB; const bf16* vb_ = (const bf16*)VB;
        char* shm = (char*)lds;
        const int nP = 1024, nS = 2048;
        const int perP = (nP + G - 1) / G, perS = (nS + G - 1) / G;
#ifndef NO_GQA
        bool nomax;
        { const int ln_ = lane_now(); float gq = __builtin_fabsf(args.in[4][ln_]), gk = __builtin_fabsf(args.in[5][ln_]);
#pragma unroll
          for (int o_ = 1; o_ < 64; o_ <<= 1) { gq = __builtin_fmaxf(gq, __shfl_xor(gq, o_)); gk = __builtin_fmaxf(gk, __shfl_xor(gk, o_)); }
          nomax = __builtin_amdgcn_readfirstlane((int)(11.78f * gq * gk <= 40.0f)) != 0; }
        { int slot = 0; bool pre = false; bf16* o = (bf16*)QAB;
        for (int li = 0; li < perP + perS; ++li) {
            const bool isP = li < perP; const int idx = isP ? vcu * perP + li : vcu * perS + (li - perP);
            if (idx >= (isP ? nP : nS)) continue;
            const int grp = isP ? idx >> 6 : idx >> 5, w = isP ? idx & 63 : idx & 31, b = grp >> 1, kvh = grp & 1, h = kvh * 4 + (isP ? w >> 4 : w >> 3), qb = isP ? w & 15 : w & 7;
            const size_t rb = isP ? (size_t)b * 4096 : (size_t)MP + (size_t)b * 2048; const int ntile = isP ? 64 : 32;
            const bf16* nK = nullptr; const bf16* nV = nullptr;
            { const int l2 = li + 1; if (l2 < perP + perS) { const bool p2 = l2 < perP; const int i2 = p2 ? vcu * perP + l2 : vcu * perS + (l2 - perP);
                if (i2 < (p2 ? nP : nS)) { const int g2 = p2 ? i2 >> 6 : i2 >> 5; const size_t rb2 = p2 ? (size_t)(g2 >> 1) * 4096 : (size_t)MP + (size_t)(g2 >> 1) * 2048; nK = kava + rb2 * 256 + (g2 & 1) * 64; nV = nK + 128; } } }
            if (nomax) slot = attn_body::attn_unit<-1, false>(q + (rb + qb * 256) * 1024 + h * 64, o + (rb + qb * 256) * 1024 + h * 64, 1024, kava + rb * 256 + kvh * 64, kava + rb * 256 + 128 + kvh * 64, 256, ntile, shm, nullptr, 0, 0, 0, wave, slot, pre, nK, nV);
            else       slot = attn_body::attn_unit<8, false>(q + (rb + qb * 256) * 1024 + h * 64, o + (rb + qb * 256) * 1024 + h * 64, 1024, kava + rb * 256 + kvh * 64, kava + rb * 256 + 128 + kvh * 64, 256, ntile, shm, nullptr, 0, 0, 0, wave, slot, pre, nK, nV);
            pre = nK != nullptr;
        } }
#endif
#ifndef NO_NA
        { int slot = 0; bool pre = false;
        for (int li = 0; li < perP + perS; ++li) {
            const attn_body::NaUnit u0 = attn_body::na_unit_of(li, vcu, perP, perS, nP, nS), u1 = attn_body::na_unit_of(li + 1, vcu, perP, perS, nP, nS);
            if (!u0.ok) continue;
            const bf16* nK = u1.ok ? kb_ + u1.koff : nullptr; const bf16* nV = u1.ok ? vb_ + u1.koff : nullptr;
            slot = attn_body::attn_unit<8, true>(q + u0.qoff, o + u0.qoff, 1024, kb_ + u0.koff, vb_ + u0.koff, 512, u0.nt, shm, args.in[6] + u0.h * 465, u0.lo, 4 * u0.qb, u0.rows, wave, slot, pre, nK, nV);
            pre = u1.ok;
        } }
#endif
    }
#endif
    xcd_barrier(xbar);

#if PH_MASK & (1 << 3)
    {
        pg8::Gemm g{QAB, Wp_t, 1024, 1024, MTOK, 1024, 1024}; pg8::StaticOrder S; S.init(MTOK, 1024, G, bx);
        pg8::EpiGate E{GT, MG};
        pg8::gemm_phase<pg8::EpiGate, pg8::StaticOrder, true, true>(ldsp, g, S, E, wave);
    }
#endif
    xcd_barrier(xbar);

#if PH_MASK & (1 << 4)
    {
        pg8::Gemm g{MG, Wo_t, 1024, 1024, MTOK, 1024, 1024}; pg8::StaticOrder S; S.init(MTOK, 1024, G, bx); S.rev = true;
        pg8::EpiH E{XN, HB, ss};
        pg8::gemm_phase<pg8::EpiH, pg8::StaticOrder, true, true>(ldsp, g, S, E, wave);
    }
#endif
    xcd_barrier(xbar);

#if PH_MASK & (1 << 5)
    {
        pg8::Gemm g{HB, Wup_t, 1024, 1024, MTOK, FF, 1024}; pg8::StaticOrder S; S.init(MTOK, FF, G, bx);
        pg8::EpiUp E{ss, U};
        pg8::gemm_phase<pg8::EpiUp, pg8::StaticOrder, true, true>(ldsp, g, S, E, wave);
#if PROBE_DUP == 5
        pg8::gemm_phase<pg8::EpiUp, pg8::StaticOrder, true, true>(ldsp, g, S, E, wave);
#endif
    }
#endif
    xcd_barrier(xbar);

#if PH_MASK & (1 << 6)
    {
        pg8::Gemm g{U, Wdn_t, FF, FF, MTOK, 1024, FF}; pg8::StaticOrder S; S.init(MTOK, 1024, G, bx); S.rev = true;
#if PROBE_DUP == 6
        { pg8::EpiH2 E0{HB, ss, (bf16*)out}; pg8::gemm_phase<pg8::EpiH2, pg8::StaticOrder, true, true>(ldsp, g, S, E0, wave); }
#endif
        pg8::EpiH2 E{HB, ss2, HB};
        pg8::gemm_phase<pg8::EpiH2, pg8::StaticOrder, true, true>(ldsp, g, S, E, wave);
    }
#endif
    xcd_barrier(xbar);

#if PH_MASK & (1 << 7)
    {
        int tid = (wave << 6) | lane_now(); asm volatile("" : "+v"(tid)); const int lane = tid & 63;
        const int gw = vcu * NWAVES + wave, NGW = G * NWAVES;
        for (int m = gw; m < MTOK; m += 4 * NGW) {
            v4u h[4][2]; float sq[4]; int mm[4];
#pragma unroll
            for (int r = 0; r < 4; ++r) { mm[r] = (m + r * NGW < MTOK) ? m + r * NGW : m; sq[r] = ss2[mm[r]];
#pragma unroll
                for (int j = 0; j < 2; ++j) h[r][j] = __builtin_nontemporal_load((const GAS v4u*)(HB + (size_t)mm[r] * 1024) + lane + 64 * j); }
#pragma unroll
            for (int r = 0; r < 4; ++r) { const float rs = __builtin_amdgcn_rsqf(sq[r] * (1.f / 1024.f) + 1e-6f); float* orow = out + (size_t)mm[r] * 1024;
#pragma unroll
                for (int j = 0; j < 2; ++j) { const int c = (lane + 64 * j) * 8; const v4u hh = h[r][j];
                    const f32x4 g0 = *(const GAS f32x4*)(args.in[13] + c), g1 = *(const GAS f32x4*)(args.in[13] + c + 4);
                    f32x4 a, b; a[0] = pg8::bflo(hh.x); a[1] = pg8::bfhi(hh.x); a[2] = pg8::bflo(hh.y); a[3] = pg8::bfhi(hh.y); b[0] = pg8::bflo(hh.z); b[1] = pg8::bfhi(hh.z); b[2] = pg8::bflo(hh.w); b[3] = pg8::bfhi(hh.w);
                    *(GAS f32x4*)(orow + c) = a * rs * g0; *(GAS f32x4*)(orow + c + 4) = b * rs * g1; } } }
    }
#endif
}

extern "C" void kernel_launch(void* const* d_in, const int* in_sizes, int n_in, void* d_out, int out_size, void* d_ws, size_t ws_size, hipStream_t stream) {
    static int grid = 0;
    if (grid == 0) {
        if (n_in != 14 || in_sizes[0] != MP * 1024 || in_sizes[1] != MS * 1024 || out_size != MTOK * 1024 || ws_size < WS_END) {
            fprintf(stderr, "kernel_launch: unexpected shapes / workspace (n_in %d, ws %zu); nothing launched\n", n_in, ws_size); grid = -1; return; }
        int dev = 0, cus = 0, per_cu = 0;
        (void)hipGetDevice(&dev); (void)hipDeviceGetAttribute(&cus, hipDeviceAttributeMultiprocessorCount, dev);
        (void)hipFuncSetAttribute((const void*)fwd_kernel, hipFuncAttributeMaxDynamicSharedMemorySize, LDS_BYTES);
        (void)hipOccupancyMaxActiveBlocksPerMultiprocessor(&per_cu, (const void*)fwd_kernel, NWAVES * 64, LDS_BYTES);
        (void)hipGetLastError();
        if (per_cu < 1) per_cu = 1;
        grid = cus * 1;
        if (grid <= 0) { grid = -1; return; }
    }
    if (grid < 0) return;
    (void)hipMemsetAsync((unsigned char*)d_ws + WS_BAR, 0, XCD_BAR_WORDS * 4, stream);
    Args a{};
    for (int i = 0; i < 14; ++i) a.in[i] = (const float*)d_in[i];
    a.out = (float*)d_out; a.ws = (unsigned char*)d_ws;
    void* kargs[] = {&a};
    hipError_t e = hipLaunchCooperativeKernel((const void*)fwd_kernel, dim3(grid), dim3(NWAVES * 64), kargs, LDS_BYTES, stream);
    if (e != hipSuccess) fprintf(stderr, "cooperative launch failed: %s (grid %d)\n", hipGetErrorString(e), grid);
}
```

```cpp
#include <hip/hip_runtime.h>
#include <hip/hip_cooperative_groups.h>
#include <hip/hip_bf16.h>
#include <cstdio>
#include <cstdint>
#include <cmath>
namespace cg = cooperative_groups;

__device__ __forceinline__ int lane_now() { int l; asm volatile("v_mbcnt_lo_u32_b32 %0, -1, 0\n\tv_mbcnt_hi_u32_b32 %0, -1, %0" : "=v"(l)); return l; }
namespace pg8 {
#define PG8_LAS __attribute__((address_space(3)))
typedef unsigned short bf16_t;
typedef short bf16x8 __attribute__((ext_vector_type(8)));
typedef float f32x4 __attribute__((ext_vector_type(4)));
typedef unsigned u32x4 __attribute__((ext_vector_type(4)));
constexpr int BM = 256, BK = 64, HALF = 128, HTB = HALF * BK * 2, STAGE_BYTES = 8 * HTB, NXCD = 8, WGM = 8;
constexpr float C2Q = 0.125f * 1.4426950408889634f;
constexpr float LOG2E = 1.4426950408889634f;

__host__ __device__ __forceinline__ int lds_byte(int r, int c) { const int st = (r >> 4) * 2 + (c >> 5), rr = r & 15, cc = c & 31, ob = rr * 64 + cc * 2; return st * 1024 + (ob ^ (((ob >> 9) & 1) << 5)); }
__host__ __device__ __forceinline__ void stage_rc(int b, int& R, int& C) { const int st = b / 1024, sb = b % 1024, swz = sb ^ (((sb >> 9) & 1) << 5); R = (st >> 1) * 16 + swz / 64; C = (st & 1) * 32 + (swz % 64) / 2; }
__host__ __device__ __forceinline__ int perm32(int rho) { const int n = rho >> 4, i = rho & 15; return 8 * (i >> 2) + 4 * n + (i & 3); }

struct Unit { int pm, pn; };
struct Gemm { const bf16_t* A; const bf16_t* Bt; int lda, ldb; int M, N, K; };

struct StaticOrder {
    int nM, nN, nwg, G, c; bool rev;
    __host__ __device__ void init(int M, int N, int G_, int c_) { nM = M / BM; nN = N / BM; nwg = nM * nN; G = G_; c = c_; rev = false; }
    __host__ __device__ bool next(int i, Unit& u) const {
        const long L = (long)i * G + c; if (L >= nwg) return false;
        int wgid = (int)L; { const int q = nwg / NXCD, r = nwg % NXCD, xcd = wgid % NXCD, off = wgid / NXCD; wgid = (xcd < r ? xcd * (q + 1) : r * (q + 1) + (xcd - r) * q) + off; }
        const int nig = WGM * nN, gid = wgid / nig, fm = gid * WGM, gsz = (nM - fm) < WGM ? (nM - fm) : WGM;
        u.pm = fm + ((wgid % nig) % gsz); u.pn = (wgid % nig) / gsz; if (rev) u.pm = nM - 1 - u.pm; return true;
    }
    __device__ __forceinline__ void a_ready(const Unit&) const {}
    __device__ __forceinline__ void done(const Unit&) const {}
};

typedef float f32x2 __attribute__((ext_vector_type(2)));
typedef __bf16 bf16x2v __attribute__((ext_vector_type(2)));
__device__ __forceinline__ unsigned pkbf(float lo, float hi) { f32x2 v = {lo, hi}; bf16x2v b = __builtin_convertvector(v, bf16x2v); return __builtin_bit_cast(unsigned, b); }
__device__ __forceinline__ float bflo(unsigned w) { return __uint_as_float(w << 16); }
__device__ __forceinline__ float bfhi(unsigned w) { return __uint_as_float(w & 0xffff0000u); }
__device__ __forceinline__ u32x4 pk8(const f32x4 a, const f32x4 b) { u32x4 w; w.x = pkbf(a[0], a[1]); w.y = pkbf(a[2], a[3]); w.z = pkbf(b[0], b[1]); w.w = pkbf(b[2], b[3]); return w; }
__device__ __forceinline__ float sigm(float v) { return __builtin_amdgcn_rcpf(1.0f + __builtin_amdgcn_exp2f(-LOG2E * v)); }
__device__ __forceinline__ float sumsq4(const f32x4 a) { return (a[0] * a[0] + a[1] * a[1]) + (a[2] * a[2] + a[3] * a[3]); }

struct EpiIn {
    static constexpr bool PERM = true, AFTER_DRAIN = false, HAS_PRE = true; static constexpr int MIDK = 0;
    bf16_t *QAB, *KAVA, *KB, *VB, *G; const float* qg; const float* kg; const float* rope; const float* ssx;
    __device__ __forceinline__ void pre(const Unit& u, int wr, int fr, float (&pf)[8]) const {
        const int row0 = u.pm * BM + wr * 64 + fr;
#pragma unroll
        for (int ai = 0; ai < 2; ++ai)
#pragma unroll
            for (int m = 0; m < 4; ++m) pf[ai * 4 + m] = ssx[(size_t)(row0 + ai * HALF + m * 16)];
    }
    __device__ __forceinline__ void operator()(const f32x4 (&acc)[2][2][4][2], const Unit& u, int wr, int wc, int fr, int fq, const float (&pf)[8]) const {
        const int pn = u.pn; const int row0 = u.pm * BM + wr * 64 + fr;
        if (pn < 3) {
            const bool isq = pn < 2, nrm = isq || wc < 2;
            bf16_t* dst = isq ? QAB : KAVA; const int pitch = isq ? 1024 : 256; const int colb = (isq ? 256 * pn : 0) + 64 * wc + 8 * fq;
            const float osc = isq ? C2Q : 1.f; const float* gp = isq ? qg : kg;
            f32x4 gv[2][2];
#pragma unroll
            for (int bj = 0; bj < 2; ++bj)
#pragma unroll
                for (int n = 0; n < 2; ++n) gv[bj][n] = *(const f32x4*)(gp + 32 * bj + 8 * fq + 4 * n);
            const bool prompt = u.pm < 128; const int smask = prompt ? 4095 : 2047, toff = prompt ? 0 : 32768;
#pragma unroll
            for (int ai = 0; ai < 2; ++ai) {
                const int grow = (((u.pm * BM + ai * HALF + wr * 64) - toff) & smask) >> 6;
                const f32x4 cr0 = *(const f32x4*)(rope + (grow * 16 + 4 * fq) * 2), cr1 = *(const f32x4*)(rope + (grow * 16 + 4 * fq + 2) * 2);
#pragma unroll
                for (int m = 0; m < 4; ++m) {
                    const int row = row0 + ai * HALF + m * 16; const int gcol = m * 16 + fr; const float rsx = __builtin_amdgcn_rsqf(pf[ai * 4 + m] * (1.0f / 1024.0f) + 1e-6f);
                    f32x4 v[2][2];
#pragma unroll
                    for (int bj = 0; bj < 2; ++bj)
#pragma unroll
                        for (int n = 0; n < 2; ++n) v[bj][n] = acc[ai][bj][m][n] * rsx;
                    if (nrm) {
                        float ss = (sumsq4(v[0][0]) + sumsq4(v[0][1])) + (sumsq4(v[1][0]) + sumsq4(v[1][1]));
                        ss += __shfl_xor(ss, 16); ss += __shfl_xor(ss, 32);
                        const float rinv = __builtin_amdgcn_rsqf(ss * (1.0f / 64.0f) + 1e-6f);
                        const f32x4 cc0 = *(const f32x4*)(rope + (gcol * 16 + 4 * fq) * 2), cc1 = *(const f32x4*)(rope + (gcol * 16 + 4 * fq + 2) * 2);
#pragma unroll
                        for (int bj = 0; bj < 2; ++bj)
#pragma unroll
                            for (int n = 0; n < 2; ++n) {
                                const f32x4 x = v[bj][n] * rinv * gv[bj][n]; const f32x4 cs = bj == 0 ? (n == 0 ? cr0 : cr1) : (n == 0 ? cc0 : cc1);
                                f32x4 o; o[0] = x[0] * cs[0] - x[1] * cs[1]; o[1] = x[0] * cs[1] + x[1] * cs[0]; o[2] = x[2] * cs[2] - x[3] * cs[3]; o[3] = x[2] * cs[3] + x[3] * cs[2];
                                v[bj][n] = o * osc; }
                    }
                    bf16_t* rowp = dst + (size_t)row * pitch + colb;
                    *(u32x4*)(rowp) = pk8(v[0][0], v[0][1]); *(u32x4*)(rowp + 32) = pk8(v[1][0], v[1][1]);
                }
            }
        } else {
            const int t = pn - 3; bf16_t* dst; int pitch, colt; float sc = 1.f; bool sg = false;
            if (t < 2) { dst = QAB; pitch = 1024; colt = 512 + 256 * t; sc = C2Q; } else if (t < 4) { dst = KB; pitch = 512; colt = 256 * (t - 2); }
            else if (t < 6) { dst = VB; pitch = 512; colt = 256 * (t - 4); } else { dst = G; pitch = 2048; colt = 128 * (t - 6); sg = true; }
            const int col0 = colt + wc * 32 + 8 * fq;
            if (sg) {
#pragma unroll
                for (int ai = 0; ai < 2; ++ai)
#pragma unroll
                    for (int m = 0; m < 4; ++m) { bf16_t* rowp = dst + (size_t)(row0 + ai * HALF + m * 16) * pitch + col0; const float rsl = -LOG2E * __builtin_amdgcn_rsqf(pf[ai * 4 + m] * (1.0f / 1024.0f) + 1e-6f);
                        f32x4 r0, r1, s0, s1;
#pragma unroll
                        for (int i = 0; i < 4; ++i) { const float ea0 = __builtin_amdgcn_exp2f(rsl * acc[ai][0][m][0][i]), ea1 = __builtin_amdgcn_exp2f(rsl * acc[ai][0][m][1][i]);
                            const float eb0 = __builtin_amdgcn_exp2f(rsl * acc[ai][1][m][0][i]), eb1 = __builtin_amdgcn_exp2f(rsl * acc[ai][1][m][1][i]);
                            s0[i] = __builtin_amdgcn_rcpf(1.0f + eb0); s1[i] = __builtin_amdgcn_rcpf(1.0f + eb1);
                            r0[i] = (1.0f + eb0) * __builtin_amdgcn_rcpf(1.0f + ea0); r1[i] = (1.0f + eb1) * __builtin_amdgcn_rcpf(1.0f + ea1); }
                        *(u32x4*)(rowp) = pk8(r0, r1); *(u32x4*)(rowp + 1024) = pk8(s0, s1); }
                return;
            }
#pragma unroll
            for (int ai = 0; ai < 2; ++ai)
#pragma unroll
                for (int m = 0; m < 4; ++m) { bf16_t* rowp = dst + (size_t)(row0 + ai * HALF + m * 16) * pitch + col0; const float rsx = __builtin_amdgcn_rsqf(pf[ai * 4 + m] * (1.0f / 1024.0f) + 1e-6f);
#pragma unroll
                    for (int bj = 0; bj < 2; ++bj) { f32x4 v0 = acc[ai][bj][m][0] * rsx, v1 = acc[ai][bj][m][1] * rsx;
                        if (sg) {
#pragma unroll
                            for (int i = 0; i < 4; ++i) { v0[i] = sigm(v0[i]); v1[i] = sigm(v1[i]); } }
                        else { v0 = v0 * sc; v1 = v1 * sc; }
                        *(u32x4*)(rowp + bj * HALF) = pk8(v0, v1); } }
        }
    }
};
struct EpiGate {
    static constexpr bool PERM = true, AFTER_DRAIN = false, HAS_PRE = false; static constexpr int MIDK = 8;
    const bf16_t* G; bf16_t* MG;
    __device__ __forceinline__ void scale(f32x4 (&acc)[2][2][4][2], const Unit& u, int wr, int wc, int fr, int fq, int goff) const {
        asm volatile("" : "+v"(fr), "+v"(fq));
        const int row0 = u.pm * BM + wr * 64 + fr, col0 = u.pn * BM + wc * 32 + 8 * fq;
#pragma unroll
        for (int ai = 0; ai < 2; ++ai)
#pragma unroll
            for (int m = 0; m < 4; ++m) { const size_t row = (size_t)(row0 + ai * HALF + m * 16);
#pragma unroll
                for (int bj = 0; bj < 2; ++bj) { const u32x4 g = __builtin_nontemporal_load((const u32x4*)(G + row * 2048 + goff + col0 + bj * HALF));
                    f32x4& v0 = acc[ai][bj][m][0]; f32x4& v1 = acc[ai][bj][m][1];
                    v0[0] *= bflo(g.x); v0[1] *= bfhi(g.x); v0[2] *= bflo(g.y); v0[3] *= bfhi(g.y); v1[0] *= bflo(g.z); v1[1] *= bfhi(g.z); v1[2] *= bflo(g.w); v1[3] *= bfhi(g.w); }
                if (m & 1) asm volatile("" ::: "memory"); }
    }
    __device__ __forceinline__ void mid(f32x4 (&acc)[2][2][4][2], const Unit& u, int wr, int wc, int fr, int fq) const { scale(acc, u, wr, wc, fr, fq, 0); }
    __device__ __forceinline__ void operator()(const f32x4 (&acc)[2][2][4][2], const Unit& u, int wr, int wc, int fr, int fq) const {
        asm volatile("" : "+v"(fr), "+v"(fq));
        const int row0 = u.pm * BM + wr * 64 + fr, col0 = u.pn * BM + wc * 32 + 8 * fq;
#pragma unroll
        for (int ai = 0; ai < 2; ++ai)
#pragma unroll
            for (int m = 0; m < 4; ++m) { const size_t row = (size_t)(row0 + ai * HALF + m * 16);
#pragma unroll
                for (int bj = 0; bj < 2; ++bj) { const u32x4 g = __builtin_nontemporal_load((const u32x4*)(G + row * 2048 + 1024 + col0 + bj * HALF));
                    f32x4 v0 = acc[ai][bj][m][0], v1 = acc[ai][bj][m][1];
                    v0[0] *= bflo(g.x); v0[1] *= bfhi(g.x); v0[2] *= bflo(g.y); v0[3] *= bfhi(g.y); v1[0] *= bflo(g.z); v1[1] *= bfhi(g.z); v1[2] *= bflo(g.w); v1[3] *= bfhi(g.w);
                    *(u32x4*)(MG + row * 1024 + col0 + bj * HALF) = pk8(v0, v1); } }
    }
};
struct EpiH {
    static constexpr bool PERM = true, AFTER_DRAIN = false, HAS_PRE = false; static constexpr int MIDK = 0;
    const bf16_t* XB; bf16_t* HB; float* ss;
    __device__ __forceinline__ void operator()(const f32x4 (&acc)[2][2][4][2], const Unit& u, int wr, int wc, int fr, int fq) const {
        const int row0 = u.pm * BM + wr * 64 + fr, col0 = u.pn * BM + wc * 32 + 8 * fq;
#pragma unroll
        for (int ai = 0; ai < 2; ++ai)
#pragma unroll
            for (int m = 0; m < 4; ++m) { const size_t row = (size_t)(row0 + ai * HALF + m * 16); float s = 0.f;
#pragma unroll
                for (int bj = 0; bj < 2; ++bj) { const size_t off = row * 1024 + col0 + bj * HALF; const u32x4 h = __builtin_nontemporal_load((const u32x4*)(XB + off));
                    f32x4 a = acc[ai][bj][m][0], b = acc[ai][bj][m][1];
                    a[0] += bflo(h.x); a[1] += bfhi(h.x); a[2] += bflo(h.y); a[3] += bfhi(h.y); b[0] += bflo(h.z); b[1] += bfhi(h.z); b[2] += bflo(h.w); b[3] += bfhi(h.w);
                    s += sumsq4(a) + sumsq4(b); *(u32x4*)(HB + off) = pk8(a, b); }
                s += __shfl_xor(s, 16); s += __shfl_xor(s, 32);
                if (fq == 0) unsafeAtomicAdd(ss + row, s); }
    }
};
struct EpiH2 {
    static constexpr bool PERM = true, AFTER_DRAIN = false, HAS_PRE = false; static constexpr int MIDK = 0;
    bf16_t* HB; float* ss; bf16_t* HO;
    __device__ __forceinline__ void operator()(const f32x4 (&acc)[2][2][4][2], const Unit& u, int wr, int wc, int fr, int fq) const {
        const int row0 = u.pm * BM + wr * 64 + fr, col0 = u.pn * BM + wc * 32 + 8 * fq;
#pragma unroll
        for (int ai = 0; ai < 2; ++ai)
#pragma unroll
            for (int m = 0; m < 4; ++m) { const size_t row = (size_t)(row0 + ai * HALF + m * 16); float s = 0.f;
#pragma unroll
                for (int bj = 0; bj < 2; ++bj) { const size_t off = row * 1024 + col0 + bj * HALF; const u32x4 h = *(const u32x4*)(HB + off);
                    f32x4 a = acc[ai][bj][m][0], b = acc[ai][bj][m][1];
                    a[0] += bflo(h.x); a[1] += bfhi(h.x); a[2] += bflo(h.y); a[3] += bfhi(h.y); b[0] += bflo(h.z); b[1] += bfhi(h.z); b[2] += bflo(h.w); b[3] += bfhi(h.w);
                    s += sumsq4(a) + sumsq4(b); *(u32x4*)(HO + off) = pk8(a, b); }
                s += __shfl_xor(s, 16); s += __shfl_xor(s, 32);
                if (fq == 0) unsafeAtomicAdd(ss + row, s); }
    }
};
struct EpiUp {
    static constexpr bool PERM = true, AFTER_DRAIN = false, HAS_PRE = true; static constexpr int MIDK = 0;
    const float* ss; bf16_t* U;
    __device__ __forceinline__ void pre(const Unit& u, int wr, int fr, float (&pf)[8]) const {
        const int row0 = u.pm * BM + wr * 64 + fr;
#pragma unroll
        for (int ai = 0; ai < 2; ++ai)
#pragma unroll
            for (int m = 0; m < 4; ++m) pf[ai * 4 + m] = ss[(size_t)(row0 + ai * HALF + m * 16)];
    }
    __device__ __forceinline__ void operator()(const f32x4 (&acc)[2][2][4][2], const Unit& u, int wr, int wc, int fr, int fq, const float (&pf)[8]) const {
        const int row0 = u.pm * BM + wr * 64 + fr, col0 = u.pn * BM + wc * 32 + 8 * fq;
#pragma unroll
        for (int ai = 0; ai < 2; ++ai)
#pragma unroll
            for (int m = 0; m < 4; ++m) { const size_t row = (size_t)(row0 + ai * HALF + m * 16); const float rs = __builtin_amdgcn_rsqf(pf[ai * 4 + m] * (1.0f / 1024.0f) + 1e-6f);
#pragma unroll
                for (int bj = 0; bj < 2; ++bj) { f32x4 v0 = acc[ai][bj][m][0] * rs, v1 = acc[ai][bj][m][1] * rs;
#pragma unroll
                    for (int i = 0; i < 4; ++i) { const float a = __builtin_fmaxf(v0[i], 0.f), b = __builtin_fmaxf(v1[i], 0.f); v0[i] = a * a; v1[i] = b * b; }
                    *(u32x4*)(U + row * 4096 + col0 + bj * HALF) = pk8(v0, v1); } }
    }
};

template <class Epi, class Sched, bool ALIGN_EPI = false, bool SP2 = false>
__device__ __forceinline__ void gemm_phase(PG8_LAS unsigned char* lds, const Gemm g, const Sched& S, const Epi& E, const int wave_s) {
    int tid_ = (wave_s << 6) | lane_now(); asm volatile("" : "+v"(tid_));
    const int tid = tid_, wid = __builtin_amdgcn_readfirstlane(tid >> 6), lane = tid & 63, wr = wid >> 2, wc = wid & 3, fr = lane & 15, fq = lane >> 4;
    const int K = g.K, nt = K / BK, lda = g.lda, ldb = g.ldb;
    unsigned voffA[2], voffB[2];
#pragma unroll
    for (int i = 0; i < 2; ++i) { int R, C; stage_rc(tid * 16 + i * 8192, R, C); const int Rb = Epi::PERM ? ((R & ~31) + perm32(R & 31)) : R;
        voffA[i] = (unsigned)(R * lda + C) * 2u; voffB[i] = (unsigned)(Rb * ldb + C) * 2u; }
    const size_t kstep = (size_t)(BK * 2);
    const size_t hA = (size_t)HALF * lda * 2, hB = (size_t)HALF * ldb * 2;
    const size_t tA = 2 * hA, tB = 2 * hB;
    const unsigned ldsw = (unsigned)wid * 1024u;
    const int aoff = lds_byte(wr * 64 + fr, fq * 8), boff = lds_byte(wc * 32 + fr, fq * 8);
#define PG8_SA(b, h) (((b) * 2 + (h)) * HTB)
#define PG8_SB(b, h) ((4 + (b) * 2 + (h)) * HTB)
#define PG8_STAGE(bufoff, gbase, voff) do { _Pragma("unroll") for (int _i = 0; _i < 2; ++_i) \
        __builtin_amdgcn_global_load_lds((const unsigned*)((const char*)(gbase) + (voff)[_i]), (PG8_LAS unsigned*)(lds + (bufoff) + ldsw + _i * 8192), 16, 0, 0); } while (0)
#define PG8_LDA(dst, b, h) do { _Pragma("unroll") for (int m = 0; m < 4; ++m) _Pragma("unroll") for (int k = 0; k < 2; ++k) dst[m][k] = *(const PG8_LAS bf16x8*)(lds + PG8_SA(b, h) + aoff + m * 2048 + k * 1024); } while (0)
#define PG8_LDB(dst, b, h) do { _Pragma("unroll") for (int n = 0; n < 2; ++n) _Pragma("unroll") for (int k = 0; k < 2; ++k) dst[n][k] = *(const PG8_LAS bf16x8*)(lds + PG8_SB(b, h) + boff + n * 2048 + k * 1024); } while (0)
#define PG8_MMA(ai, bj, At, Bt) do { __builtin_amdgcn_s_setprio(1); _Pragma("unroll") for (int m = 0; m < 4; ++m) _Pragma("unroll") for (int n = 0; n < 2; ++n) _Pragma("unroll") for (int k = 0; k < 2; ++k) \
        acc[ai][bj][m][n] = __builtin_amdgcn_mfma_f32_16x16x32_bf16(Bt[n][k], At[m][k], acc[ai][bj][m][n], 0, 0, 0); __builtin_amdgcn_s_setprio(0); } while (0)
#define PG8_WAIT_V(n) asm volatile("s_waitcnt vmcnt(" #n ")" ::: "memory")
#define PG8_WAIT_L(n) asm volatile("s_waitcnt lgkmcnt(" #n ")" ::: "memory")
#define PG8_BAR __builtin_amdgcn_s_barrier()
#define PG8_SCHED __builtin_amdgcn_sched_barrier(0)
    Unit cur, nxt; int ui = 0; float pf[8] = {0.f, 0.f, 0.f, 0.f, 0.f, 0.f, 0.f, 0.f};
    if (!S.next(0, cur)) return;
    f32x4 acc[2][2][4][2];
#pragma unroll
    for (int a = 0; a < 2; ++a)
#pragma unroll
        for (int b = 0; b < 2; ++b)
#pragma unroll
            for (int m = 0; m < 4; ++m)
#pragma unroll
                for (int n = 0; n < 2; ++n) acc[a][b][m][n] = (f32x4){0.f, 0.f, 0.f, 0.f};
    bf16x8 At[4][2], B0[2][2], B1[2][2];
    const char* cA = (const char*)g.A + (size_t)cur.pm * tA; const char* cB = (const char*)g.Bt + (size_t)cur.pn * tB;
    S.a_ready(cur);
    if constexpr (SP2) {
        PG8_STAGE(PG8_SB(0, 0), cB, voffB); PG8_STAGE(PG8_SB(0, 1), cB + hB, voffB); PG8_STAGE(PG8_SA(0, 0), cA, voffA); PG8_STAGE(PG8_SA(0, 1), cA + hA, voffA);
        if (wr == 1) PG8_BAR;
        PG8_WAIT_V(2); PG8_BAR;
        PG8_STAGE(PG8_SB(1, 0), cB + kstep, voffB); PG8_STAGE(PG8_SA(1, 0), cA + kstep, voffA); PG8_STAGE(PG8_SB(1, 1), cB + hB + kstep, voffB);
        PG8_WAIT_V(6); PG8_BAR;
    } else {
        PG8_STAGE(PG8_SB(0, 0), cB, voffB); PG8_STAGE(PG8_SA(0, 0), cA, voffA); PG8_STAGE(PG8_SB(0, 1), cB + hB, voffB); PG8_STAGE(PG8_SA(0, 1), cA + hA, voffA);
        if (wr == 1) PG8_BAR;
        PG8_WAIT_V(4); PG8_BAR;
        PG8_STAGE(PG8_SB(1, 0), cB + kstep, voffB); PG8_STAGE(PG8_SA(1, 0), cA + kstep, voffA); PG8_STAGE(PG8_SB(1, 1), cB + hB + kstep, voffB);
        PG8_WAIT_V(6); PG8_BAR;
    }
    for (;;) {
        const bool has_next = S.next(ui + 1, nxt);
        const char* nA = has_next ? (const char*)g.A + (size_t)nxt.pm * tA : cA; const char* nB = has_next ? (const char*)g.Bt + (size_t)nxt.pn * tB : cB;
        for (int t = 0; t < nt; t += 2) {
            if constexpr (Epi::MIDK > 0) { if (t == Epi::MIDK) E.mid(acc, cur, wr, wc, fr, fq); }
            const bool last = (t == nt - 2);
            if constexpr (Epi::HAS_PRE) { if (last) E.pre(cur, wr, fr, pf); }
            const char* a1 = cA + (size_t)(t + 1) * kstep;
            const char* a2 = last ? nA : cA + (size_t)(t + 2) * kstep; const char* b2 = last ? nB : cB + (size_t)(t + 2) * kstep;
            const char* a3 = a2 + kstep; const char* b3 = b2 + kstep;
            if (last && has_next) S.a_ready(nxt);
            if constexpr (SP2) {
            PG8_LDB(B0, 0, 0); PG8_LDB(B1, 0, 1); PG8_SCHED; PG8_LDA(At, 0, 0); PG8_STAGE(PG8_SA(1, 1), a1 + hA, voffA);
            PG8_WAIT_V(8); PG8_WAIT_L(0); PG8_BAR; PG8_MMA(0, 0, At, B0); PG8_MMA(0, 1, At, B1); PG8_BAR; PG8_SCHED;
            PG8_LDA(At, 0, 1); PG8_STAGE(PG8_SB(0, 0), b2, voffB); PG8_STAGE(PG8_SB(0, 1), b2 + hB, voffB); PG8_STAGE(PG8_SA(0, 0), a2, voffA);
            PG8_WAIT_V(8); PG8_WAIT_L(0); PG8_BAR; PG8_MMA(1, 0, At, B0); PG8_MMA(1, 1, At, B1); PG8_BAR; PG8_SCHED;
            PG8_LDB(B0, 1, 0); PG8_LDB(B1, 1, 1); PG8_SCHED; PG8_LDA(At, 1, 0); PG8_STAGE(PG8_SA(0, 1), a2 + hA, voffA);
            PG8_WAIT_V(8); PG8_WAIT_L(0); PG8_BAR; PG8_MMA(0, 0, At, B0); PG8_MMA(0, 1, At, B1); PG8_BAR; PG8_SCHED;
            PG8_LDA(At, 1, 1); PG8_STAGE(PG8_SB(1, 0), b3, voffB); PG8_STAGE(PG8_SB(1, 1), b3 + hB, voffB); PG8_STAGE(PG8_SA(1, 0), a3, voffA);
            PG8_WAIT_V(8); PG8_WAIT_L(0); PG8_BAR; PG8_MMA(1, 0, At, B0); PG8_MMA(1, 1, At, B1); PG8_BAR; PG8_SCHED;
            } else {
            PG8_LDB(B0, 0, 0); PG8_SCHED; PG8_LDA(At, 0, 0); PG8_STAGE(PG8_SA(1, 1), a1 + hA, voffA);
            PG8_WAIT_L(8); PG8_BAR; PG8_WAIT_L(0); PG8_MMA(0, 0, At, B0); PG8_BAR; PG8_SCHED;
            PG8_LDB(B1, 0, 1); PG8_STAGE(PG8_SB(0, 0), b2, voffB);
            PG8_BAR; PG8_WAIT_L(0); PG8_MMA(0, 1, At, B1); PG8_BAR;
            PG8_LDA(At, 0, 1); PG8_STAGE(PG8_SA(0, 0), a2, voffA);
            PG8_BAR; PG8_WAIT_L(0); PG8_MMA(1, 0, At, B0); PG8_BAR; PG8_SCHED;
            PG8_STAGE(PG8_SB(0, 1), b2 + hB, voffB);
            PG8_WAIT_V(6); PG8_BAR; PG8_MMA(1, 1, At, B1); PG8_BAR;
            PG8_LDB(B0, 1, 0); PG8_SCHED; PG8_LDA(At, 1, 0); PG8_STAGE(PG8_SA(0, 1), a2 + hA, voffA);
            PG8_WAIT_L(8); PG8_BAR; PG8_WAIT_L(0); PG8_MMA(0, 0, At, B0); PG8_BAR; PG8_SCHED;
            PG8_LDB(B1, 1, 1); PG8_STAGE(PG8_SB(1, 0), b3, voffB);
            PG8_BAR; PG8_WAIT_L(0); PG8_MMA(0, 1, At, B1); PG8_BAR;
            PG8_LDA(At, 1, 1); PG8_STAGE(PG8_SA(1, 0), a3, voffA);
            PG8_BAR; PG8_WAIT_L(0); PG8_MMA(1, 0, At, B0); PG8_BAR; PG8_SCHED;
            PG8_STAGE(PG8_SB(1, 1), b3 + hB, voffB);
            PG8_WAIT_V(6); PG8_BAR; PG8_MMA(1, 1, At, B1); PG8_BAR;
            }
        }
        if constexpr (ALIGN_EPI) { if (wr == 0) PG8_BAR; }
        if constexpr (!Epi::AFTER_DRAIN) { if constexpr (Epi::HAS_PRE) E(acc, cur, wr, wc, fr, fq, pf); else E(acc, cur, wr, wc, fr, fq); S.done(cur); }
        if (!has_next) break;
#pragma unroll
        for (int a = 0; a < 2; ++a)
#pragma unroll
            for (int b = 0; b < 2; ++b)
#pragma unroll
                for (int m = 0; m < 4; ++m)
#pragma unroll
                    for (int n = 0; n < 2; ++n) acc[a][b][m][n] = (f32x4){0.f, 0.f, 0.f, 0.f};
        cur = nxt; cA = nA; cB = nB; ++ui;
        if constexpr (ALIGN_EPI) { if (wr == 1) PG8_BAR; }
    }
    PG8_WAIT_V(0);
    if constexpr (!ALIGN_EPI) { if (wr == 0) PG8_BAR; }
    PG8_BAR;
    if constexpr (Epi::AFTER_DRAIN) { E.fused(acc, cur, wr, wc, fr, fq, lds, wid, lane); S.done(cur); }
#undef PG8_SA
#undef PG8_SB
#undef PG8_STAGE
#undef PG8_LDA
#undef PG8_LDB
#undef PG8_MMA
#undef PG8_WAIT_V
#undef PG8_WAIT_L
#undef PG8_BAR
#undef PG8_SCHED
}
}

namespace attn_body {
using bf16=__hip_bfloat16;
using bf16x8=__attribute__((ext_vector_type(8)))short;
using s16x4=__attribute__((ext_vector_type(4)))short;
using f32x16=__attribute__((ext_vector_type(16)))float;
using u32x4=__attribute__((ext_vector_type(4)))unsigned;
constexpr int D=64;
constexpr int NW=8,QBLK=32,QB=QBLK*NW,KVBLK=64;
constexpr int NA_TBL_OFF=88064;
typedef const __attribute__((address_space(3))) float* na_lptr;
__device__ __forceinline__ int crow(int r,int hi){return (r&3)+8*(r>>2)+4*hi;}
#define SBAR() __builtin_amdgcn_sched_barrier(0)
#define ATTN_STORE16(p,v) (*(u32x4*)(p)=(v))
#define NA_SETUP \
  int na_qr=0,na_off=0,na_rsw=0; unsigned na_mw=0u; na_lptr na_tbl=(na_lptr)((const __attribute__((address_space(3))) char*)shm+NA_TBL_OFF); \
  if constexpr(NA){ na_qr=qrow0+(wid>>1); const int na_qc=32*(wid&1)+r32; na_off=15-na_qc+4*hi; { int a_=na_qr-4; a_=a_<0?0:a_; const int m_=nrows-8; na_rsw=a_>m_?m_:a_; } \
    { int c_=na_qc-8; c_=c_<0?0:c_; c_=c_>48?48:c_; _Pragma("unroll") for(int r=0;r<16;++r){ const int kc_=(r&3)+8*(r>>2)+4*hi; na_mw|=(((unsigned)(kc_-c_)<16u)?1u:0u)<<r; na_mw|=(((unsigned)(kc_+32-c_)<16u)?1u:0u)<<(16+r); } } \
    if(tid<465)((__attribute__((address_space(3))) float*)((__attribute__((address_space(3))) char*)shm+NA_TBL_OFF))[tid]=rpbh[tid]*1.4426950408889634f; }
#define NA_LD(D,W,R4) do{ _Pragma("unroll") for(int i_=0;i_<4;++i_) D[i_]=tp_[(((R4)+i_)&3)+8*(((R4)+i_)>>2)+32*(W)]; }while(0)
#define NA_CP(S_,P,W,R4) do{ _Pragma("unroll") for(int i_=0;i_<4;++i_){ unsigned m_; asm("v_bfe_i32 %0, %1, %2, 1":"=v"(m_):"v"(mw_),"n"(16*(W)+(R4)+i_)); const float x_=P[(R4)+i_]+(S_[i_]-mhat); P[(R4)+i_]=__uint_as_float((__float_as_uint(x_)&m_)|(0xFF800000u&~m_)); } }while(0)
#define NAMASK(P0,P1,t) do{ if constexpr(NA){ const int kr_=b0+(t); f32x16&P0_=P0; f32x16&P1_=P1; \
   if(kr_>=na_rsw && kr_<na_rsw+8){ const na_lptr tp_=na_tbl+((kr_-na_qr+7)*31+na_off); unsigned mw_=na_mw; asm volatile("":"+v"(mw_)); float ga_[4],gb_[4]; \
     if((wid&1)==0){ \
       NA_LD(ga_,0,0); NA_LD(gb_,0,4); SBAR(); NA_CP(ga_,P0_,0,0); NA_LD(ga_,0,8); SBAR(); NA_CP(gb_,P0_,0,4); NA_LD(gb_,0,12); SBAR(); \
       NA_CP(ga_,P0_,0,8); NA_LD(ga_,1,0); SBAR(); NA_CP(gb_,P0_,0,12); SBAR(); NA_CP(ga_,P1_,1,0); \
       _Pragma("unroll") for(int r=4;r<16;++r)P1_[r]=-INFINITY; \
     } else { \
       NA_LD(ga_,0,12); NA_LD(gb_,1,0); SBAR(); NA_CP(ga_,P0_,0,12); NA_LD(ga_,1,4); SBAR(); NA_CP(gb_,P1_,1,0); NA_LD(gb_,1,8); SBAR(); \
       NA_CP(ga_,P1_,1,4); NA_LD(ga_,1,12); SBAR(); NA_CP(gb_,P1_,1,8); SBAR(); NA_CP(ga_,P1_,1,12); \
       _Pragma("unroll") for(int r=0;r<12;++r)P0_[r]=-INFINITY; \
     } } \
   else { _Pragma("unroll") for(int r=0;r<16;++r){P0_[r]=-INFINITY;P1_[r]=-INFINITY;} } } }while(0)
constexpr int NSLOT=3, SLOTB=8192;
constexpr int LDS_K=0, LDS_V=NSLOT*SLOTB, LDS_WS=2*NSLOT*SLOTB, LDS_OST=LDS_WS+NW*64*4, LDS_BYTES=LDS_OST+NW*4096;
constexpr float C2=0.125f*1.4426950408889634f;
__device__ __forceinline__ void glds16(const void*gsrc,unsigned lds_dst){unsigned keep;
  asm volatile("s_mov_b32 %0, m0\n\ts_mov_b32 m0, %2\n\ts_nop 0\n\tglobal_load_lds_dwordx4 %1, off\n\ts_mov_b32 m0, %0":"=&s"(keep):"v"(gsrc),"s"(lds_dst):"memory");}
__device__ __forceinline__ float max3f(float a,float b,float c){float r;asm("v_max3_f32 %0, %1, %2, %3":"=v"(r):"v"(a),"v"(b),"v"(c));return r;}
__device__ __forceinline__ float max2f(float a,float b){float r;asm("v_max_f32_e32 %0, %1, %2":"=v"(r):"v"(a),"v"(b));return r;}
__device__ __forceinline__ float fadd_s(float a,float b){float r;asm("v_add_f32_e32 %0, %1, %2":"=v"(r):"v"(a),"v"(b));return r;}
__device__ __forceinline__ float fsub_s(float a,float b){float r;asm("v_sub_f32_e32 %0, %1, %2":"=v"(r):"v"(a),"v"(b));return r;}
typedef float f32x2_t __attribute__((ext_vector_type(2))); typedef __bf16 bf16x2_t __attribute__((ext_vector_type(2)));
__device__ __forceinline__ unsigned cvtpk_s(float lo,float hi){f32x2_t v={lo,hi};bf16x2_t b=__builtin_convertvector(v,bf16x2_t);return __builtin_bit_cast(unsigned,b);}
#define WAIT_BAR(N) asm volatile("s_waitcnt vmcnt(" #N ") lgkmcnt(0)\n\ts_barrier":::"memory")

__device__ __forceinline__ void qkt(f32x16&p0,f32x16&p1,const char*Kslot,const bf16x8*qr,const f32x16&negm,int r32,int hi){
  const char*kb=Kslot+hi*1024+r32*16;
  #pragma unroll
  for(int d0=0;d0<4;++d0){
    const bf16x8 b0=*reinterpret_cast<const bf16x8*>(kb+d0*2048);
    const bf16x8 b1=*reinterpret_cast<const bf16x8*>(kb+d0*2048+512);
    if(d0==0){p0=__builtin_amdgcn_mfma_f32_32x32x16_bf16(b0,qr[0],negm,0,0,0);p1=__builtin_amdgcn_mfma_f32_32x32x16_bf16(b1,qr[0],negm,0,0,0);}
    else{p0=__builtin_amdgcn_mfma_f32_32x32x16_bf16(b0,qr[d0],p0,0,0,0);p1=__builtin_amdgcn_mfma_f32_32x32x16_bf16(b1,qr[d0],p1,0,0,0);}}
}
typedef __attribute__((address_space(3))) const char* lds_cptr;
typedef short v4i16_t __attribute__((ext_vector_type(4)));
__device__ __forceinline__ void kload8(bf16x8*kf,lds_cptr kp){
  kf[0]=*(const __attribute__((address_space(3))) bf16x8*)(kp);      kf[1]=*(const __attribute__((address_space(3))) bf16x8*)(kp+512);
  kf[2]=*(const __attribute__((address_space(3))) bf16x8*)(kp+2048); kf[3]=*(const __attribute__((address_space(3))) bf16x8*)(kp+2560);
  kf[4]=*(const __attribute__((address_space(3))) bf16x8*)(kp+4096); kf[5]=*(const __attribute__((address_space(3))) bf16x8*)(kp+4608);
  kf[6]=*(const __attribute__((address_space(3))) bf16x8*)(kp+6144); kf[7]=*(const __attribute__((address_space(3))) bf16x8*)(kp+6656);
}
__device__ __forceinline__ void kload2(bf16x8*kf,lds_cptr kp,int j){ kf[2*j]=*(const __attribute__((address_space(3))) bf16x8*)(kp+j*2048); kf[2*j+1]=*(const __attribute__((address_space(3))) bf16x8*)(kp+j*2048+512); }
__device__ __forceinline__ s16x4 vtr(lds_cptr p){ return __builtin_bit_cast(s16x4,__builtin_amdgcn_ds_read_tr16_b64_v4i16((__attribute__((address_space(3))) v4i16_t*)p)); }
__device__ __forceinline__ float rowmax(const f32x16&p0,const f32x16&p1){
  float a=max3f(p0[0],p0[1],p1[0]),b=max3f(p0[2],p0[3],p1[1]);a=max3f(a,p1[2],p1[3]);
  #pragma unroll
  for(int r=4;r<16;r+=4){a=max3f(a,p0[r],p0[r+1]);b=max3f(b,p0[r+2],p0[r+3]);a=max3f(a,p1[r],p1[r+1]);b=max3f(b,p1[r+2],p1[r+3]);}
  const float m=max2f(a,b);
  auto rr=__builtin_amdgcn_permlane32_swap(__float_as_uint(m),__float_as_uint(m),false,false);
  return max2f(__uint_as_float(rr[0]),__uint_as_float(rr[1]));
}
__device__ __forceinline__ void pv(f32x16*o,int vb,bf16x8 pa0,bf16x8 pa1,bf16x8 pa2,bf16x8 pa3){
  #pragma unroll
  for(int d0=0;d0<2;++d0){s16x4 lo[4],hi[4];
    #pragma unroll
    for(int ks=0;ks<4;++ks){
      asm volatile("ds_read_b64_tr_b16 %0,%1 offset:%c2":"=&v"(lo[ks]):"v"(vb),"i"(d0*4096+ks*1024):"memory");
      asm volatile("ds_read_b64_tr_b16 %0,%1 offset:%c2":"=&v"(hi[ks]):"v"(vb),"i"(d0*4096+ks*1024+512):"memory");}
    asm volatile("s_waitcnt lgkmcnt(0)":::"memory");SBAR();
    #define PK(k) (bf16x8){lo[k][0],lo[k][1],lo[k][2],lo[k][3],hi[k][0],hi[k][1],hi[k][2],hi[k][3]}
    o[d0]=__builtin_amdgcn_mfma_f32_32x32x16_bf16(pa0,PK(0),o[d0],0,0,0);
    o[d0]=__builtin_amdgcn_mfma_f32_32x32x16_bf16(pa1,PK(1),o[d0],0,0,0);
    o[d0]=__builtin_amdgcn_mfma_f32_32x32x16_bf16(pa2,PK(2),o[d0],0,0,0);
    o[d0]=__builtin_amdgcn_mfma_f32_32x32x16_bf16(pa3,PK(3),o[d0],0,0,0);
    #undef PK
  }
}

template<int THRL,bool NA> __device__ __forceinline__ int attn_unit(const bf16*Qu,bf16*Ou,int qp,const bf16*__restrict__ Kh,const bf16*__restrict__ Vh,int kp,int NT,char*shm,
    const float*__restrict__ rpbh,int b0,int qrow0,int nrows,const int wave_s,const int s0b,const bool pre,const bf16*__restrict__ nKh,const bf16*__restrict__ nVh){
  int tid_=(wave_s<<6)|lane_now(); asm volatile("":"+v"(tid_)); const int tid=tid_,lane=tid&63,r32=lane&31,hi=lane>>5; const int wid=__builtin_amdgcn_readfirstlane(tid>>6);
  const bf16*Qw=Qu+(long)(wid*QBLK)*qp;
  const unsigned lds0=(unsigned)(uintptr_t)shm;
  float*wsf=(float*)(shm+LDS_WS)+wid*64;
  const bf16*ksrc=Kh+(long)lane*kp+wid*8;
  const bf16*vsrc=Vh+(long)(16*(wid&3)+(lane>>2))*kp+(wid>>2)*32+(lane&3)*8;
  const unsigned kdst=lds0+LDS_K+wid*1024, vdst=lds0+LDS_V+wid*1024;
  #define DMA_K(t,slot) glds16(ksrc+(long)(t)*KVBLK*kp,(unsigned)__builtin_amdgcn_readfirstlane(kdst+(slot)))
  #define DMA_V(t,slot) glds16(vsrc+(long)(t)*KVBLK*kp,(unsigned)__builtin_amdgcn_readfirstlane(vdst+(slot)))
  const int vb0=(int)(lds0+LDS_V)+((lane>>4)&1)*32+(lane&3)*8+(4*hi+((lane&15)>>2))*64;
  const char*Kbase=shm+LDS_K; bf16x8 kf[8];
  const lds_cptr shm3=(lds_cptr)shm; const lds_cptr kp0=shm3+LDS_K+hi*1024+r32*16; const lds_cptr vp0=shm3+LDS_V+((lane>>4)&1)*32+(lane&3)*8+(4*hi+((lane&15)>>2))*64;
  #define NXS(x) (((x)==(NSLOT-1)*SLOTB)?0:(x)+SLOTB)
  const int s1b=NXS(s0b),s2b=NXS(s1b);
  if(!pre){DMA_K(0,s0b);DMA_V(0,s0b);DMA_K(1,s1b);}
  bf16x8 qr[4];
  #pragma unroll
  for(int d0=0;d0<4;++d0)qr[d0]=*reinterpret_cast<const bf16x8*>(&Qw[(long)r32*qp+d0*16+hi*8]);
  float mhat=0.f,l_reg=0.f;f32x16 o[2];o[0]=f32x16{};o[1]=f32x16{};f32x16 negm=f32x16{};if constexpr(!NA&&THRL>=0){asm volatile("":"+v"(negm));}
  NA_SETUP
  #define NEGMC ((NA||THRL<0)?f32x16{}:negm)
  #define CMASK(P0,P1,t) NAMASK(P0,P1,t)
  bool resc=false;
  #define START(P0,P1) do{ resc=false; \
    if constexpr(THRL>=0){ const float rm=rowmax(P0,P1); const float dl=NA?__builtin_fmaxf(rm,-1000.f):rm; mhat=fadd_s(mhat,dl); \
      _Pragma("unroll") for(int r=0;r<16;++r){P0[r]=fsub_s(P0[r],dl);P1[r]=fsub_s(P1[r],dl);} \
      if constexpr(!NA){_Pragma("unroll") for(int r=0;r<16;++r)negm[r]=-mhat; asm volatile("":"+v"(negm));} } \
    _Pragma("unroll") for(int r=0;r<16;++r)P0[r]=__builtin_amdgcn_exp2f(P0[r]); }while(0)
  #define RESC() do{ if(resc){ asm volatile("s_waitcnt lgkmcnt(0)":::"memory"); \
      _Pragma("unroll") for(int d_=0;d_<2;++d_) _Pragma("unroll") for(int r=0;r<16;++r)o[d_][r]*=wsf[crow(r,hi)]; } }while(0)
  f32x16 pA0,pA1,pB0,pB1;
  int sl_prev=s0b,sl_cur=s0b,sl_next=s1b;
  #define ROT() do{sl_prev=sl_cur;sl_cur=sl_next;sl_next=(sl_next==(NSLOT-1)*SLOTB)?0:sl_next+SLOTB;}while(0)
  if(!pre){DMA_K(2,s2b);}
  WAIT_BAR(3);
  if constexpr(NA||THRL<0){const f32x16 z_=f32x16{};qkt(pA0,pA1,Kbase+s0b,qr,z_,r32,hi);}else{qkt(pA0,pA1,Kbase+s0b,qr,negm,r32,hi);}asm volatile("s_nop 15\n\ts_nop 7":"+v"(pA0),"+v"(pA1));CMASK(pA0,pA1,0);
  START(pA0,pA1);
  _Pragma("unroll") for(int r=0;r<16;++r)pA1[r]=__builtin_amdgcn_exp2f(pA1[r]);
  WAIT_BAR(0);
  DMA_K(3,s0b);DMA_V(1,s1b);
  ROT();
  kload8(kf,kp0+sl_cur);
  WAIT_BAR(2);
  s16x4 vlo[8],vhi[8]; u32x4 pw0,pw1,pw2,pw3;
  #define PKW(P,B) cvtpk_s(P[B],P[B+1])
  #define PAF(k) __builtin_bit_cast(bf16x8,pw##k)
  #define VFR(i) (bf16x8){vlo[i][0],vlo[i][1],vlo[i][2],vlo[i][3],vhi[i][0],vhi[i][1],vhi[i][2],vhi[i][3]}
  #define PIN(x) asm volatile("":"+v"(x))
  #define MX3(a,b,c) __builtin_fmaxf(__builtin_fmaxf((a),(b)),(c))
  #define GAPA(MF,A0,A1,A2,A3,W0,W1,PW) do{ MF; sacc+=A0; sacc+=A1; sacc+=A2; sacc+=A3; PIN(sacc); W0; W1; PIN(PW); SBAR(); }while(0)
  #define EX(v) __builtin_amdgcn_exp2f(v)
  #define GAPB(MF,X,B) do{ MF; X[B]=EX(X[B]); X[B+1]=EX(X[B+1]); X[B+2]=EX(X[B+2]); X[B+3]=EX(X[B+3]); PIN(X); SBAR(); }while(0)
  #define VRD(i) do{ vlo[i]=vtr(vp_+(((i)>>2)*4096+((i)&3)*1024)); vhi[i]=vtr(vp_+(((i)>>2)*4096+((i)&3)*1024+512)); }while(0)
  #define KRD(G,j) do{ if(G){ kload2(kf,kp0+sl_next,j); SBAR(); } }while(0)
  #define STEP(C0,C1,P0,P1,t,GK,GV,GL) do{ SBAR(); \
    const lds_cptr vp_=vp0+sl_prev; \
    VRD(0); SBAR(); float sacc=(P0[0]+P0[1]); \
    GAPA(C0=__builtin_amdgcn_mfma_f32_32x32x16_bf16(kf[0],qr[0],NEGMC,0,0,0), P0[2],P0[3],P0[4],P0[5],     pw0[0]=PKW(P0,0), pw0[1]=PKW(P0,2), pw0); \
    VRD(4); SBAR(); GAPA(C1=__builtin_amdgcn_mfma_f32_32x32x16_bf16(kf[1],qr[0],NEGMC,0,0,0), P0[6],P0[7],P0[8],P0[9],     pw0[2]=PKW(P0,4), pw0[3]=PKW(P0,6), pw0); \
    VRD(1); SBAR(); GAPA(C0=__builtin_amdgcn_mfma_f32_32x32x16_bf16(kf[2],qr[1],C0,0,0,0),   P0[10],P0[11],P0[12],P0[13], pw1[0]=PKW(P0,8), pw1[1]=PKW(P0,10), pw1); \
    VRD(5); SBAR(); GAPA(C1=__builtin_amdgcn_mfma_f32_32x32x16_bf16(kf[3],qr[1],C1,0,0,0),   P0[14],P0[15],P1[0],P1[1],   pw1[2]=PKW(P0,12),pw1[3]=PKW(P0,14), pw1); \
    VRD(2); SBAR(); GAPA(C0=__builtin_amdgcn_mfma_f32_32x32x16_bf16(kf[4],qr[2],C0,0,0,0),   P1[2],P1[3],P1[4],P1[5],     pw2[0]=PKW(P1,0), pw2[1]=PKW(P1,2), pw2); \
    VRD(6); SBAR(); GAPA(C1=__builtin_amdgcn_mfma_f32_32x32x16_bf16(kf[5],qr[2],C1,0,0,0),   P1[6],P1[7],P1[8],P1[9],     pw2[2]=PKW(P1,4), pw2[3]=PKW(P1,6), pw2); \
    VRD(3); SBAR(); GAPA(C0=__builtin_amdgcn_mfma_f32_32x32x16_bf16(kf[6],qr[3],C0,0,0,0),   P1[10],P1[11],P1[12],P1[13], pw3[0]=PKW(P1,8), pw3[1]=PKW(P1,10), pw3); \
    VRD(7); SBAR(); GAPA(C1=__builtin_amdgcn_mfma_f32_32x32x16_bf16(kf[7],qr[3],C1,0,0,0),   P1[14],P1[15],0.f,0.f,       pw3[2]=PKW(P1,12),pw3[3]=PKW(P1,14), pw3); \
    l_reg+=sacc; \
    if(GK){DMA_K((t)+3,sl_cur);} if(GV){DMA_V((t)+1,sl_next);} \
    CMASK(C0,C1,t); \
    resc=false; if constexpr(THRL>=0){ float a=MX3(C0[0],C0[1],C1[0]),b=MX3(C0[2],C0[3],C1[1]); a=MX3(a,C1[2],C1[3]); \
      _Pragma("unroll") for(int r=4;r<16;r+=4){a=MX3(a,C0[r],C0[r+1]);b=MX3(b,C0[r+2],C0[r+3]);a=MX3(a,C1[r],C1[r+1]);b=MX3(b,C1[r+2],C1[r+3]);} \
      float rm=__builtin_fmaxf(a,b); { auto rr=__builtin_amdgcn_permlane32_swap(__float_as_uint(rm),__float_as_uint(rm),false,false); rm=__builtin_fmaxf(__uint_as_float(rr[0]),__uint_as_float(rr[1])); } \
      resc=false; \
      if(__builtin_expect(__any(rm>(float)THRL),0)){ const float dl=__builtin_fmaxf(rm,0.f); mhat+=dl; \
        _Pragma("unroll") for(int r=0;r<16;++r){C0[r]-=dl;C1[r]-=dl;} \
        if constexpr(!NA){_Pragma("unroll") for(int r=0;r<16;++r)negm[r]=-mhat; asm volatile("":"+v"(negm));} \
        const float f=__builtin_amdgcn_exp2f(-dl); l_reg*=f; { const int l_=lane_now(); if(l_<32)wsf[l_]=f; } resc=true; } } \
    SBAR(); \
    GAPB(o[0]=__builtin_amdgcn_mfma_f32_32x32x16_bf16(PAF(0),VFR(0),o[0],0,0,0), C0,0); \
    GAPB(o[1]=__builtin_amdgcn_mfma_f32_32x32x16_bf16(PAF(0),VFR(4),o[1],0,0,0), C0,4); \
    KRD(GL,0); GAPB(o[0]=__builtin_amdgcn_mfma_f32_32x32x16_bf16(PAF(1),VFR(1),o[0],0,0,0), C0,8); \
    KRD(GL,1); GAPB(o[1]=__builtin_amdgcn_mfma_f32_32x32x16_bf16(PAF(1),VFR(5),o[1],0,0,0), C0,12); \
    KRD(GL,2); GAPB(o[0]=__builtin_amdgcn_mfma_f32_32x32x16_bf16(PAF(2),VFR(2),o[0],0,0,0), C1,0); \
    KRD(GL,3); GAPB(o[1]=__builtin_amdgcn_mfma_f32_32x32x16_bf16(PAF(2),VFR(6),o[1],0,0,0), C1,4); \
    GAPB(o[0]=__builtin_amdgcn_mfma_f32_32x32x16_bf16(PAF(3),VFR(3),o[0],0,0,0), C1,8); \
    GAPB(o[1]=__builtin_amdgcn_mfma_f32_32x32x16_bf16(PAF(3),VFR(7),o[1],0,0,0), C1,12); \
    }while(0)
  int t=1;
  for(;t+5<NT;t+=2){
    STEP(pB0,pB1,pA0,pA1,t,true,true,true);     WAIT_BAR(2); RESC(); ROT();
    STEP(pA0,pA1,pB0,pB1,t+1,true,true,true);   WAIT_BAR(2); RESC(); ROT();
  }
  #define ENDW(tt) do{ if((tt)+3<NT){WAIT_BAR(2);} else if((tt)+2<NT){WAIT_BAR(1);} else {WAIT_BAR(0);} }while(0)
  for(;t+1<NT;t+=2){
    STEP(pB0,pB1,pA0,pA1,t,(t+3<NT),(t+1<NT),(t+1<NT));       ENDW(t);   RESC(); ROT();
    STEP(pA0,pA1,pB0,pB1,t+1,(t+4<NT),(t+2<NT),(t+2<NT));     ENDW(t+1); RESC(); ROT();
  }
  STEP(pB0,pB1,pA0,pA1,NT-1,false,false,false); RESC();
  if(nKh){ const bf16*nks=nKh+(long)lane*kp+wid*8; const bf16*nvs=nVh+(long)(16*(wid&3)+(lane>>2))*kp+(wid>>2)*32+(lane&3)*8; const int n1=NXS(sl_next),n2=NXS(n1);
    glds16(nks,(unsigned)__builtin_amdgcn_readfirstlane(kdst+sl_next)); glds16(nvs,(unsigned)__builtin_amdgcn_readfirstlane(vdst+sl_next));
    glds16(nks+(long)KVBLK*kp,(unsigned)__builtin_amdgcn_readfirstlane(kdst+n1)); glds16(nks+(long)2*KVBLK*kp,(unsigned)__builtin_amdgcn_readfirstlane(kdst+n2)); }
  { float sacc=pB0[0]+pB0[1]; _Pragma("unroll") for(int r=2;r<16;++r)sacc+=pB0[r]; _Pragma("unroll") for(int r=0;r<16;++r)sacc+=pB1[r]; l_reg+=sacc;
    pw0=(u32x4){PKW(pB0,0),PKW(pB0,2),PKW(pB0,4),PKW(pB0,6)};pw1=(u32x4){PKW(pB0,8),PKW(pB0,10),PKW(pB0,12),PKW(pB0,14)};pw2=(u32x4){PKW(pB1,0),PKW(pB1,2),PKW(pB1,4),PKW(pB1,6)};pw3=(u32x4){PKW(pB1,8),PKW(pB1,10),PKW(pB1,12),PKW(pB1,14)};
    SBAR(); pv(o,vb0+sl_cur,PAF(0),PAF(1),PAF(2),PAF(3)); }
  #undef PKW
  #undef PAF
  #undef VFR
  #undef PIN
  #undef MX3
  #undef GAPA
  #undef GAPB
  #undef EX
  #undef VRD
  #undef KRD
  #undef STEP
  #undef ENDW
  {auto rr=__builtin_amdgcn_permlane32_swap(__float_as_uint(l_reg),__float_as_uint(l_reg),false,false);l_reg=__uint_as_float(rr[0])+__uint_as_float(rr[1]);}
  if(hi==0)wsf[32+r32]=l_reg;asm volatile("s_waitcnt lgkmcnt(0)":::"memory");
  float rli[16];
  #pragma unroll
  for(int r=0;r<16;++r)rli[r]=__builtin_amdgcn_rcpf(wsf[32+crow(r,hi)]);
  bf16*Ow=Ou+(long)(wid*QBLK)*qp;
  { bf16*stg=(bf16*)(shm+LDS_OST)+wid*2048;
    #pragma unroll
    for(int r=0;r<16;++r){const int orow=crow(r,hi);
      #pragma unroll
      for(int d0=0;d0<2;++d0)stg[orow*64+d0*32+r32]=__float2bfloat16(o[d0][r]*rli[r]);}
    asm volatile("s_waitcnt lgkmcnt(0)":::"memory");
    { const __amdgpu_buffer_rsrc_t orsrc=__builtin_amdgcn_make_buffer_rsrc((void*)Ow,(short)0,32*qp*2,0x00020000);
    #pragma unroll
    for(int i=0;i<4;++i){const int row=i*8+(lane>>3),ch=lane&7; const u32x4 v=*(const u32x4*)(stg+row*64+ch*8); __builtin_amdgcn_raw_buffer_store_b128(v,orsrc,(unsigned)((row*qp+ch*8)*2),0,16);} } }
  asm volatile("s_waitcnt lgkmcnt(0)\n\ts_barrier":::"memory");
  const int ret_slot=sl_next;
  #undef NXS
  #undef DMA_K
  #undef DMA_V
  #undef CMASK
  #undef START
  #undef RESC
  #undef ROT
  return ret_slot;
}
struct NaUnit { size_t qoff, koff; int lo, nt, h, qb, rows; bool ok; };
__device__ __forceinline__ NaUnit na_unit_of(int li, int vcu, int perP, int perS, int nP, int nS) {
  NaUnit u; u.ok = false; u.qoff = 0; u.koff = 0; u.lo = 0; u.nt = 0; u.h = 0; u.qb = 0; u.rows = 0;
  if (li >= perP + perS) return u;
  const bool isP = li < perP; const int idx = isP ? vcu * perP + li : vcu * perS + (li - perP);
  if (idx >= (isP ? nP : nS)) return u;
  const int nqb = isP ? 16 : 8, rows = isP ? 64 : 32, S = rows * 64; const int bh = idx / nqb, qb = idx % nqb, b = bh >> 3, h = bh & 7;
  const size_t rb = (isP ? (size_t)0 : (size_t)(8 * 4096)) + (size_t)b * S;
  int lo = 4 * qb - 4; lo = lo < 0 ? 0 : lo; lo = lo > rows - 8 ? rows - 8 : lo; int hi_ = 4 * qb - 1; hi_ = hi_ < 0 ? 0 : hi_; hi_ = hi_ > rows - 8 ? rows - 8 : hi_; hi_ += 8;
  int nt = hi_ - lo; nt += nt & 1; if (lo + nt > rows) lo = rows - nt;
  u.ok = true; u.qoff = (rb + (size_t)qb * 256) * 1024 + 512 + h * 64; u.koff = (rb + (size_t)lo * 64) * 512 + h * 64; u.lo = lo; u.nt = nt; u.h = h; u.qb = qb; u.rows = rows;
  return u;
}
constexpr int ATTN_LDS_BYTES=LDS_BYTES;
#undef SBAR
#undef WAIT_BAR
#undef NA_SETUP
#undef NAMASK
#undef NA_LD
#undef NA_CP
}

#ifndef PROBE_DUP
#define PROBE_DUP 0
#endif
#ifndef PH_MASK
#define PH_MASK 255
#endif
constexpr int NWAVES = 8;
constexpr int DMODEL = 1024, MP = 8 * 4096, MS = 32 * 2048, MTOK = MP + MS, NIN = 4352, FF = 4096;
constexpr size_t MiB = 1u << 20;
constexpr size_t WS_SS = 0, WS_SS2 = 1 * MiB, WS_ROPE = 2 * MiB, WS_BAR = 3 * MiB;
constexpr int MISC_OFF = 131072 + 320;
constexpr size_t WS_WIN = 4 * MiB, WS_WP = 13 * MiB, WS_WO = 15 * MiB, WS_WUP = 17 * MiB, WS_WDN = 25 * MiB;
constexpr size_t WS_QAB = 40 * MiB, WS_KAVA = 232 * MiB, WS_KB = 280 * MiB, WS_VB = 376 * MiB, WS_G = 472 * MiB, WS_U = 232 * MiB, WS_MG = 280 * MiB, WS_HB = 40 * MiB, WS_END = 1000 * MiB;
static_assert(WS_WIN + (size_t)NIN * 1024 * 2 <= WS_WP && WS_WDN + (size_t)FF * 1024 * 2 <= WS_QAB, "weights map");
static_assert(WS_QAB + (size_t)MTOK * 1024 * 2 == WS_KAVA && WS_KAVA + (size_t)MTOK * 256 * 2 == WS_KB && WS_KB + (size_t)MTOK * 512 * 2 == WS_VB && WS_VB + (size_t)MTOK * 512 * 2 == WS_G, "activation map");
static_assert(WS_G + (size_t)MTOK * 2048 * 2 <= WS_END && WS_U + (size_t)MTOK * 4096 * 2 <= WS_END, "ws end");
constexpr int LDS_BYTES = 147456;

#define GAS __attribute__((address_space(1)))
#define LAS __attribute__((address_space(3)))
typedef unsigned short bf16;
typedef unsigned v4u __attribute__((ext_vector_type(4)));
typedef float f32x4 __attribute__((ext_vector_type(4)));
#define LDS_WAIT() asm volatile("s_waitcnt lgkmcnt(0)" ::: "memory")
typedef GAS unsigned gu32;
#define RLX_AGENT __ATOMIC_RELAXED, __HIP_MEMORY_SCOPE_AGENT
#define XB_TMO      128
#define XB_XCNT(j)  (256  + 64 * (j))
#define XB_XSUB(j)  (1280 + 64 * (j))
#define XB_XGEN(j)  (2304 + 64 * (j))
#define XB_TOP      3328
#define XB_TOPGEN   3392
#define XCD_BAR_WORDS 3456
#define XB_SPIN_CAP (1u << 18)

__device__ __forceinline__ unsigned xb_ld(unsigned* p)              { return __hip_atomic_load(p, __ATOMIC_RELAXED, __HIP_MEMORY_SCOPE_AGENT); }
__device__ __forceinline__ unsigned xb_add(unsigned* p, unsigned v) { return __hip_atomic_fetch_add(p, v, __ATOMIC_RELAXED, __HIP_MEMORY_SCOPE_AGENT); }
__device__ __forceinline__ unsigned xb_xcc_id() { return (unsigned)__builtin_amdgcn_s_getreg((3 << 11) | 20) & 0xFu; }
#define XB_SPIN(cond, bar) do { unsigned _sp = 0; while (cond) { __builtin_amdgcn_s_sleep(1); \
    if ((++_sp & 255u) == 0u) { if (xb_ld(&(bar)[XB_TMO])) break; if (_sp > XB_SPIN_CAP) { atomicAdd(&(bar)[XB_TMO], 1u); break; } } } } while (0)

struct XcdBarrier {
    unsigned* bar; unsigned x; int wave;
    volatile LAS unsigned* st;
};

__device__ __forceinline__ XcdBarrier xcd_barrier_post(unsigned* bar, volatile LAS unsigned* st, int wave) {
    XcdBarrier b; b.bar = bar; b.x = xb_xcc_id(); b.st = st; b.wave = wave;
    if (wave == 0 && lane_now() == 0) (void)xb_add(&bar[XB_XCNT(b.x)], 1u);
    return b;
}
__device__ __forceinline__ void xcd_barrier_complete(unsigned* bar, unsigned x, unsigned& nloc, unsigned& nx) {
    const unsigned G = gridDim.x * gridDim.y * gridDim.z;
    unsigned sum, cnt, mine, sp = 0u;
    for (;;) {
        sum = 0u; cnt = 0u; mine = 0u;
#pragma unroll
        for (unsigned j = 0; j < 16; ++j) { const unsigned c = xb_ld(&bar[XB_XCNT(j)]); sum += c; cnt += (c > 0u) ? 1u : 0u; mine = (j == x) ? c : mine; }
        if (sum == G) break;
        __builtin_amdgcn_s_sleep(1);
        if ((++sp & 255u) == 0u) { if (xb_ld(&bar[XB_TMO])) break; if (sp > XB_SPIN_CAP) { atomicAdd(&bar[XB_TMO], 1u); break; } }
    }
    nloc = mine > 0u ? mine : 1u; nx = cnt > 0u ? cnt : 1u;
}

__device__ __forceinline__ void xcd_barrier(const XcdBarrier& b) {
    asm volatile("s_waitcnt vmcnt(0)" ::: "memory");
    __syncthreads();
    if (b.wave == 0 && lane_now() == 0) {
        unsigned* bar = b.bar;
        __builtin_amdgcn_s_waitcnt(0);
        unsigned nloc = b.st[0], nx = b.st[1];
        if (nloc == 0u) { xcd_barrier_complete(bar, b.x, nloc, nx); b.st[0] = nloc; b.st[1] = nx; }
        const unsigned old = xb_add(&bar[XB_XSUB(b.x)], 1u);
        const unsigned gen = old / nloc;
        if (old + 1u == (gen + 1u) * nloc) {
            __builtin_amdgcn_fence(__ATOMIC_RELEASE, "agent");
            asm volatile("s_waitcnt vmcnt(0)" ::: "memory");
            const unsigned og = xb_add(&bar[XB_TOP], 1u);
            const unsigned tg = og / nx;
            if (og + 1u == (tg + 1u) * nx) xb_add(&bar[XB_TOPGEN], 1u);
            else XB_SPIN(xb_ld(&bar[XB_TOPGEN]) == tg, bar);
            __builtin_amdgcn_fence(__ATOMIC_ACQUIRE, "agent");
            xb_add(&bar[XB_XGEN(b.x)], 1u);
            asm volatile("s_waitcnt vmcnt(0)" ::: "memory");
        } else {
            XB_SPIN(xb_ld(&bar[XB_XGEN(b.x)]) == gen, bar);
            __builtin_amdgcn_fence(__ATOMIC_ACQUIRE, "agent");
            asm volatile("s_waitcnt vmcnt(0)" ::: "memory");
        }
    }
    __syncthreads();
}

__device__ __forceinline__ float wave_sum(float v) {
#pragma unroll
    for (int o = 1; o < 64; o <<= 1) v += __shfl_xor(v, o);
    return v;
}
__device__ __forceinline__ void tr_item(const float* W, int N, int k0, int n0, bf16* WT, int ldt, int drow0, int dk0, const float* kscale, LAS float* scr, int lane) {
    float wv[32];
#pragma unroll
    for (int i = 0; i < 32; ++i) { const int kk = 2 * i + (lane >> 5); wv[i] = __builtin_nontemporal_load(W + (size_t)(k0 + kk) * N + n0 + (lane & 31)); }
#pragma unroll
    for (int i = 0; i < 32; ++i) { const int kk = 2 * i + (lane >> 5); float w = wv[i]; if (kscale) w *= kscale[k0 + kk]; scr[kk * 33 + (lane & 31)] = w; }
    LDS_WAIT(); asm volatile("" ::: "memory");
    const int c = lane & 7;
#pragma unroll
    for (int j = 0; j < 4; ++j) { const int n = (lane >> 3) + 8 * j; const LAS float* s = scr + (8 * c) * 33 + n;
        v4u o; o.x = pg8::pkbf(s[0 * 33], s[1 * 33]); o.y = pg8::pkbf(s[2 * 33], s[3 * 33]); o.z = pg8::pkbf(s[4 * 33], s[5 * 33]); o.w = pg8::pkbf(s[6 * 33], s[7 * 33]);
        *(GAS v4u*)(WT + (size_t)(drow0 + n) * ldt + dk0 + 8 * c) = o; }
    LDS_WAIT(); asm volatile("" ::: "memory");
}
__device__ __forceinline__ void rms_row_to_bf16(const float* xrow, const float* g, bf16* orow, int lane) {
    const GAS f32x4* xr = (const GAS f32x4*)xrow + lane; const GAS f32x4* gr = (const GAS f32x4*)g + lane;
    f32x4 v[4]; float s = 0.f;
#pragma unroll
    for (int j = 0; j < 4; ++j) { v[j] = xr[64 * j]; s += pg8::sumsq4(v[j]); }
    const float rstd = __builtin_amdgcn_rsqf(wave_sum(s) * (1.f / 1024.f) + 1e-6f);
    GAS unsigned long long* o8 = (GAS unsigned long long*)orow + lane;
#pragma unroll
    for (int j = 0; j < 4; ++j) { const f32x4 gg = gr[64 * j]; const f32x4 y = v[j] * rstd * gg; o8[64 * j] = (unsigned long long)pg8::pkbf(y[0], y[1]) | ((unsigned long long)pg8::pkbf(y[2], y[3]) << 32); }
}
__device__ __forceinline__ void cvt_row2_to_bf16(const float* xa, const float* xb, bf16* oa, bf16* ob, float* sa_out, float* sb_out, int lane) {
    const GAS f32x4* ra = (const GAS f32x4*)xa + lane; const GAS f32x4* rb = (const GAS f32x4*)xb + lane;
    f32x4 va[4], vb[4]; float sa = 0.f, sb = 0.f;
#pragma unroll
    for (int j = 0; j < 4; ++j) { va[j] = __builtin_nontemporal_load(ra + 64 * j); vb[j] = __builtin_nontemporal_load(rb + 64 * j); }
    GAS unsigned long long* pa = (GAS unsigned long long*)oa + lane; GAS unsigned long long* pb = (GAS unsigned long long*)ob + lane;
#pragma unroll
    for (int j = 0; j < 4; ++j) { sa += pg8::sumsq4(va[j]); sb += pg8::sumsq4(vb[j]);
        pa[64 * j] = (unsigned long long)pg8::pkbf(va[j][0], va[j][1]) | ((unsigned long long)pg8::pkbf(va[j][2], va[j][3]) << 32);
        pb[64 * j] = (unsigned long long)pg8::pkbf(vb[j][0], vb[j][1]) | ((unsigned long long)pg8::pkbf(vb[j][2], vb[j][3]) << 32); }
#pragma unroll
    for (int o = 1; o < 64; o <<= 1) { sa += __shfl_xor(sa, o); sb += __shfl_xor(sb, o); }
    if (lane == 0) { *sa_out = sa; *sb_out = sb; }
}
__device__ __forceinline__ void final_row(const bf16* hrow, float* orow, const float* g, float ssum, int lane) {
    const float rs = __builtin_amdgcn_rsqf(ssum * (1.f / 1024.f) + 1e-6f);
#pragma unroll
    for (int j = 0; j < 2; ++j) { const v4u h = *((const GAS v4u*)hrow + lane + 64 * j); const int c = (lane + 64 * j) * 8;
        const f32x4 g0 = *(const GAS f32x4*)(g + c), g1 = *(const GAS f32x4*)(g + c + 4);
        f32x4 a, b; a[0] = pg8::bflo(h.x); a[1] = pg8::bfhi(h.x); a[2] = pg8::bflo(h.y); a[3] = pg8::bfhi(h.y); b[0] = pg8::bflo(h.z); b[1] = pg8::bfhi(h.z); b[2] = pg8::bflo(h.w); b[3] = pg8::bfhi(h.w);
        *(GAS f32x4*)(orow + c) = a * rs * g0; *(GAS f32x4*)(orow + c + 4) = b * rs * g1; }
}

struct Args { const float* in[14]; float* out; unsigned char* ws; unsigned long long never; };

__global__ void __launch_bounds__(NWAVES * 64, 2) fwd_kernel(Args args) {
    extern __shared__ __attribute__((aligned(16))) unsigned char lds[];
    cg::grid_group grid = cg::this_grid();
    LAS unsigned char* ldsp = (LAS unsigned char*)lds;
    const int wave = __builtin_amdgcn_readfirstlane((int)threadIdx.x >> 6);
    const int G = gridDim.x; const int bx = blockIdx.x; const int vcu = (G % 8 == 0) ? (bx % 8) * (G / 8) + bx / 8 : bx;
    unsigned char* ws = args.ws;
    float* ss = (float*)(ws + WS_SS); float* ss2 = (float*)(ws + WS_SS2); float* ssx = (float*)(ws + WS_SS2 + 512 * 1024); float* rope = (float*)(ws + WS_ROPE);
    bf16* Win_t = (bf16*)(ws + WS_WIN); bf16* Wp_t = (bf16*)(ws + WS_WP); bf16* Wo_t = (bf16*)(ws + WS_WO); bf16* Wup_t = (bf16*)(ws + WS_WUP); bf16* Wdn_t = (bf16*)(ws + WS_WDN);
    bf16* QAB = (bf16*)(ws + WS_QAB); bf16* KAVA = (bf16*)(ws + WS_KAVA); bf16* KB = (bf16*)(ws + WS_KB); bf16* VB = (bf16*)(ws + WS_VB); bf16* GT = (bf16*)(ws + WS_G);
    bf16* U = (bf16*)(ws + WS_U); bf16* MG = (bf16*)(ws + WS_MG); bf16* HB = (bf16*)(ws + WS_HB);
    float* out = args.out; bf16* XN = (bf16*)out;
    volatile LAS unsigned* MISC = (volatile LAS unsigned*)(ldsp + MISC_OFF);
    if (wave == 0 && lane_now() < 32) MISC[lane_now()] = 0u;
    __syncthreads();
    unsigned* barw = (unsigned*)(ws + WS_BAR);
    if (args.never != 0) grid.sync();
    const XcdBarrier xbar = xcd_barrier_post(barw, MISC + 8, wave);

#if PH_MASK & (1 << 0)
    {
        int tid = (wave << 6) | lane_now(); asm volatile("" : "+v"(tid)); const int lane = tid & 63;
        const int gw = vcu * NWAVES + wave, NGW = G * NWAVES;
        for (int i = bx * 512 + tid; i < MTOK; i += G * 512) { ss[i] = 0.f; ss2[i] = 0.f; }
        if (bx == 0 && tid < 16) {
            double th = 1.0; for (int j = 0; j < tid; ++j) th *= 0.5623413251903491;
            double c1 = 1.0, s1 = th, tc = 1.0, tsn = th; const double t2 = th * th;
            for (int k = 1; k < 14; ++k) { tc = -tc * t2 / (double)((2 * k - 1) * (2 * k)); tsn = -tsn * t2 / (double)((2 * k) * (2 * k + 1)); c1 += tc; s1 += tsn; }
            double c = 1.0, s = 0.0;
            for (int p = 0; p < 64; ++p) { rope[(p * 16 + tid) * 2] = (float)c; rope[(p * 16 + tid) * 2 + 1] = (float)s; const double cn = c * c1 - s * s1, sn = s * c1 + c * s1; c = cn; s = sn; }
        }
        LAS float* scr = (LAS float*)(ldsp + wave * 16384);
        constexpr int I_IN = 16 * (NIN / 32), I_PA = 8 * 32, I_PB = 8 * 32, I_O = 16 * 32, I_UP = 16 * (FF / 32), I_DN = 64 * 32;
        constexpr int NITEMS = I_IN + I_PA + I_PB + I_O + I_UP + I_DN;
        for (int it = gw; it < NITEMS; it += NGW) {
            int r = it;
            if (r < I_IN) { const int nb = r % (NIN / 32), kb = r / (NIN / 32); const int n0 = nb * 32; int d0 = n0;
                if (n0 < 768) { const int pn = n0 >> 8, rem = n0 & 255, wc = rem >> 6, bj = (rem & 63) >> 5; d0 = 256 * pn + 128 * bj + 32 * wc; }
                else if (n0 >= 2304) { const int isb = n0 >= 3328, c0 = n0 - (isb ? 3328 : 2304); d0 = 2304 + 256 * (c0 >> 7) + 128 * isb + (c0 & 127); }
                tr_item(args.in[3], NIN, kb * 64, n0, Win_t, 1024, d0, kb * 64, args.in[2], scr, lane); continue; } r -= I_IN;
            if (r < I_PA) { const int nb = r % 32, kb = r / 32; tr_item(args.in[7], 1024, kb * 64, nb * 32, Wp_t, 1024, nb * 32, kb * 64, nullptr, scr, lane); continue; } r -= I_PA;
            if (r < I_PB) { const int nb = r % 32, kb = r / 32; tr_item(args.in[8], 1024, kb * 64, nb * 32, Wp_t, 1024, nb * 32, 512 + kb * 64, nullptr, scr, lane); continue; } r -= I_PB;
            if (r < I_O) { const int nb = r % 32, kb = r / 32; tr_item(args.in[9], 1024, kb * 64, nb * 32, Wo_t, 1024, nb * 32, kb * 64, nullptr, scr, lane); continue; } r -= I_O;
            if (r < I_UP) { const int nb = r % (FF / 32), kb = r / (FF / 32); tr_item(args.in[11], FF, kb * 64, nb * 32, Wup_t, 1024, nb * 32, kb * 64, args.in[10], scr, lane); continue; } r -= I_UP;
            { const int nb = r % 32, kb = r / 32; tr_item(args.in[12], 1024, kb * 64, nb * 32, Wdn_t, FF, nb * 32, kb * 64, nullptr, scr, lane); }
        }
        for (int m = gw; m < MTOK; m += 2 * NGW) {
            const int m2 = m + NGW; const bool two = m2 < MTOK; const int mb = two ? m2 : m;
            const float* xa = m < MP ? args.in[0] + (size_t)m * 1024 : args.in[1] + (size_t)(m - MP) * 1024;
            const float* xb = mb < MP ? args.in[0] + (size_t)mb * 1024 : args.in[1] + (size_t)(mb - MP) * 1024;
            cvt_row2_to_bf16(xa, xb, XN + (size_t)m * 1024, XN + (size_t)mb * 1024, ssx + m, ssx + mb, lane); }
    }
#endif
    xcd_barrier(xbar);

#if PH_MASK & (1 << 1)
    {
        pg8::Gemm g{XN, Win_t, 1024, 1024, MTOK, NIN, 1024}; pg8::StaticOrder S; S.init(MTOK, NIN, G, bx); S.rev = true;
        pg8::EpiIn E{QAB, KAVA, KB, VB, GT, args.in[4], args.in[5], rope, ssx};
        pg8::gemm_phase<pg8::EpiIn, pg8::StaticOrder, true, true>(ldsp, g, S, E, wave);
    }
#endif
    xcd_barrier(xbar);

#if PH_MASK & (1 << 2)
    {
        using attn_body::bf16; const bf16* q = (const bf16*)QAB; bf16* o = (bf16*)QAB; const bf16* kava = (const bf16*)KAVA; const bf16* kb_ = (const bf16*)KB; const bf16* vb_ = (const bf16*)VB;
        char* shm = (char*)lds;
        const int nP = 1024, nS = 2048;
        const int perP = (nP + G - 1) / G, perS = (nS + G - 1) / G;
#ifndef NO_GQA
        bool nomax;
        { const int ln_ = lane_now(); float gq = __builtin_fabsf(args.in[4][ln_]), gk = __builtin_fabsf(args.in[5][ln_]);
#pragma unroll
          for (int o_ = 1; o_ < 64; o_ <<= 1) { gq = __builtin_fmaxf(gq, __shfl_xor(gq, o_)); gk = __builtin_fmaxf(gk, __shfl_xor(gk, o_)); }
          nomax = __builtin_amdgcn_readfirstlane((int)(11.78f * gq * gk <= 40.0f)) != 0; }
        { int slot = 0; bool pre = false; bf16* o = (bf16*)QAB;
        for (int li = 0; li < perP + perS; ++li) {
            const bool isP = li < perP; const int idx = isP ? vcu * perP + li : vcu * perS + (li - perP);
            if (idx >= (isP ? nP : nS)) continue;
            const int grp = isP ? idx >> 6 : idx >> 5, w = isP ? idx & 63 : idx & 31, b = grp >> 1, kvh = grp & 1, h = kvh * 4 + (isP ? w >> 4 : w >> 3), qb = isP ? w & 15 : w & 7;
            const size_t rb = isP ? (size_t)b * 4096 : (size_t)MP + (size_t)b * 2048; const int ntile = isP ? 64 : 32;
            const bf16* nK = nullptr; const bf16* nV = nullptr;
            { const int l2 = li + 1; if (l2 < perP + perS) { const bool p2 = l2 < perP; const int i2 = p2 ? vcu * perP + l2 : vcu * perS + (l2 - perP);
                if (i2 < (p2 ? nP : nS)) { const int g2 = p2 ? i2 >> 6 : i2 >> 5; const size_t rb2 = p2 ? (size_t)(g2 >> 1) * 4096 : (size_t)MP + (size_t)(g2 >> 1) * 2048; nK = kava + rb2 * 256 + (g2 & 1) * 64; nV = nK + 128; } } }
            if (nomax) slot = attn_body::attn_unit<-1, false>(q + (rb + qb * 256) * 1024 + h * 64, o + (rb + qb * 256) * 1024 + h * 64, 1024, kava + rb * 256 + kvh * 64, kava + rb * 256 + 128 + kvh * 64, 256, ntile, shm, nullptr, 0, 0, 0, wave, slot, pre, nK, nV);
            else       slot = attn_body::attn_unit<8, false>(q + (rb + qb * 256) * 1024 + h * 64, o + (rb + qb * 256) * 1024 + h * 64, 1024, kava + rb * 256 + kvh * 64, kava + rb * 256 + 128 + kvh * 64, 256, ntile, shm, nullptr, 0, 0, 0, wave, slot, pre, nK, nV);
            pre = nK != nullptr;
        } }
#endif
#ifndef NO_NA
        { int slot = 0; bool pre = false;
        for (int li = 0; li < perP + perS; ++li) {
            const attn_body::NaUnit u0 = attn_body::na_unit_of(li, vcu, perP, perS, nP, nS), u1 = attn_body::na_unit_of(li + 1, vcu, perP, perS, nP, nS);
            if (!u0.ok) continue;
            const bf16* nK = u1.ok ? kb_ + u1.koff : nullptr; const bf16* nV = u1.ok ? vb_ + u1.koff : nullptr;
            slot = attn_body::attn_unit<8, true>(q + u0.qoff, o + u0.qoff, 1024, kb_ + u0.koff, vb_ + u0.koff, 512, u0.nt, shm, args.in[6] + u0.h * 465, u0.lo, 4 * u0.qb, u0.rows, wave, slot, pre, nK, nV);
            pre = u1.ok;
        } }
#endif
    }
#endif
    xcd_barrier(xbar);

#if PH_MASK & (1 << 3)
    {
        pg8::Gemm g{QAB, Wp_t, 1024, 1024, MTOK, 1024, 1024}; pg8::StaticOrder S; S.init(MTOK, 1024, G, bx);
        pg8::EpiGate E{GT, MG};
        pg8::gemm_phase<pg8::EpiGate, pg8::StaticOrder, true, true>(ldsp, g, S, E, wave);
    }
#endif
    xcd_barrier(xbar);

#if PH_MASK & (1 << 4)
    {
        pg8::Gemm g{MG, Wo_t, 1024, 1024, MTOK, 1024, 1024}; pg8::StaticOrder S; S.init(MTOK, 1024, G, bx); S.rev = true;
        pg8::EpiH E{XN, HB, ss};
        pg8::gemm_phase<pg8::EpiH, pg8::StaticOrder, true, true>(ldsp, g, S, E, wave);
    }
#endif
    xcd_barrier(xbar);

#if PH_MASK & (1 << 5)
    {
        pg8::Gemm g{HB, Wup_t, 1024, 1024, MTOK, FF, 1024}; pg8::StaticOrder S; S.init(MTOK, FF, G, bx);
        pg8::EpiUp E{ss, U};
        pg8::gemm_phase<pg8::EpiUp, pg8::StaticOrder, true, true>(ldsp, g, S, E, wave);
#if PROBE_DUP == 5
        pg8::gemm_phase<pg8::EpiUp, pg8::StaticOrder, true, true>(ldsp, g, S, E, wave);
#endif
    }
#endif
    xcd_barrier(xbar);

#if PH_MASK & (1 << 6)
    {
        pg8::Gemm g{U, Wdn_t, FF, FF, MTOK, 1024, FF}; pg8::StaticOrder S; S.init(MTOK, 1024, G, bx); S.rev = true;
#if PROBE_DUP == 6
        { pg8::EpiH2 E0{HB, ss, (bf16*)out}; pg8::gemm_phase<pg8::EpiH2, pg8::StaticOrder, true, true>(ldsp, g, S, E0, wave); }
#endif
        pg8::EpiH2 E{HB, ss2, HB};
        pg8::gemm_phase<pg8::EpiH2, pg8::StaticOrder, true, true>(ldsp, g, S, E, wave);
    }
#endif
    xcd_barrier(xbar);

#if PH_MASK & (1 << 7)
    {
        int tid = (wave << 6) | lane_now(); asm volatile("" : "+v"(tid)); const int lane = tid & 63;
        const int gw = vcu * NWAVES + wave, NGW = G * NWAVES;
        for (int m = gw; m < MTOK; m += 4 * NGW) {
            v4u h[4][2]; float sq[4]; int mm[4];
#pragma unroll
            for (int r = 0; r < 4; ++r) { mm[r] = (m + r * NGW < MTOK) ? m + r * NGW : m; sq[r] = ss2[mm[r]];
#pragma unroll
                for (int j = 0; j < 2; ++j) h[r][j] = __builtin_nontemporal_load((const GAS v4u*)(HB + (size_t)mm[r] * 1024) + lane + 64 * j); }
#pragma unroll
            for (int r = 0; r < 4; ++r) { const float rs = __builtin_amdgcn_rsqf(sq[r] * (1.f / 1024.f) + 1e-6f); float* orow = out + (size_t)mm[r] * 1024;
#pragma unroll
                for (int j = 0; j < 2; ++j) { const int c = (lane + 64 * j) * 8; const v4u hh = h[r][j];
                    const f32x4 g0 = *(const GAS f32x4*)(args.in[13] + c), g1 = *(const GAS f32x4*)(args.in[13] + c + 4);
                    f32x4 a, b; a[0] = pg8::bflo(hh.x); a[1] = pg8::bfhi(hh.x); a[2] = pg8::bflo(hh.y); a[3] = pg8::bfhi(hh.y); b[0] = pg8::bflo(hh.z); b[1] = pg8::bfhi(hh.z); b[2] = pg8::bflo(hh.w); b[3] = pg8::bfhi(hh.w);
                    *(GAS f32x4*)(orow + c) = a * rs * g0; *(GAS f32x4*)(orow + c + 4) = b * rs * g1; } } }
    }
#endif
}

extern "C" void kernel_launch(void* const* d_in, const int* in_sizes, int n_in, void* d_out, int out_size, void* d_ws, size_t ws_size, hipStream_t stream) {
    static int grid = 0;
    if (grid == 0) {
        if (n_in != 14 || in_sizes[0] != MP * 1024 || in_sizes[1] != MS * 1024 || out_size != MTOK * 1024 || ws_size < WS_END) {
            fprintf(stderr, "kernel_launch: unexpected shapes / workspace (n_in %d, ws %zu); nothing launched\n", n_in, ws_size); grid = -1; return; }
        int dev = 0, cus = 0, per_cu = 0;
        (void)hipGetDevice(&dev); (void)hipDeviceGetAttribute(&cus, hipDeviceAttributeMultiprocessorCount, dev);
        (void)hipFuncSetAttribute((const void*)fwd_kernel, hipFuncAttributeMaxDynamicSharedMemorySize, LDS_BYTES);
        (void)hipOccupancyMaxActiveBlocksPerMultiprocessor(&per_cu, (const void*)fwd_kernel, NWAVES * 64, LDS_BYTES);
        (void)hipGetLastError();
        if (per_cu < 1) per_cu = 1;
        grid = cus * 1;
        if (grid <= 0) { grid = -1; return; }
    }
    if (grid < 0) return;
    (void)hipMemsetAsync((unsigned char*)d_ws + WS_BAR, 0, XCD_BAR_WORDS * 4, stream);
    Args a{};
    for (int i = 0; i < 14; ++i) a.in[i] = (const float*)d_in[i];
    a.out = (float*)d_out; a.ws = (unsigned char*)d_ws;
    void* kargs[] = {&a};
    hipError_t e = hipLaunchCooperativeKernel((const void*)fwd_kernel, dim3(grid), dim3(NWAVES * 64), kargs, LDS_BYTES, stream);
    if (e != hipSuccess) fprintf(stderr, "cooperative launch failed: %s (grid %d)\n", hipGetErrorString(e), grid);
}
```
